# Optimizing an MI355X kernel written in HIP

```python
import jax
import jax.numpy as jnp
from jax import lax
import numpy as np

D_MODEL = 1024
BATCH = 16
SEQ = 2048
DEPTH = 2

CTX_LEN = 256
GRID_W = 64
D_MIX = D_MODEL
HEAD_DIM = 64
D_POOL = D_MIX // 4
D_RWKV = (D_MIX - D_POOL) // 2
D_HGRN = D_MIX - D_POOL - D_RWKV
POOL_WINDOWS = (2, 4, 8, 16)
N_POOL_GROUPS = len(POOL_WINDOWS)
POOL_GROUP = D_POOL // N_POOL_GROUPS
H_RWKV = D_RWKV // HEAD_DIM
H_HGRN = D_HGRN // HEAD_DIM
LORA_W = 64
LORA_A = 64
N_DIR = 2
HGRN_CHUNK = 32
D_RWKV_IN = 3 * D_RWKV + N_DIR * (LORA_W + LORA_A)
D_IN = D_POOL + D_RWKV_IN + 2 * D_HGRN + N_DIR * D_HGRN + D_MIX
ALPHA = float((2 * DEPTH) ** 0.25)
BETA = float((8 * DEPTH) ** -0.25)
LN_EPS = 1e-5
GN_EPS = 64e-5
RMS_EPS = 1e-6

kernel_name = "hybrid_pool_rwkv7_hgrn2_flow_block"


def _layer_norm(x):
    xf = x.astype(jnp.float32)
    mu = jnp.mean(xf, axis=-1, keepdims=True)
    var = jnp.mean(jnp.square(xf - mu), axis=-1, keepdims=True)
    return (xf - mu) * lax.rsqrt(var + LN_EPS)


def _heads(z):
    return z.reshape(z.shape[:-1] + (z.shape[-1] // HEAD_DIM, HEAD_DIM))


def _split_proj(p):
    o0 = D_POOL
    o1 = o0 + D_RWKV_IN
    o2 = o1 + 2 * D_HGRN + N_DIR * D_HGRN
    return p[..., :o0], p[..., o0:o1], p[..., o1:o2], p[..., o2:]


def _centred_mean(u, axis, window):
    n = u.shape[axis]
    left = window // 2
    right = window - 1 - left
    t = jnp.arange(n)
    lo = jnp.maximum(t - left, 0)
    hi = jnp.minimum(t + right, n - 1) + 1
    pad = [(0, 0)] * u.ndim
    pad[axis] = (1, 0)
    cs = jnp.pad(jnp.cumsum(u, axis=axis), pad)
    total = jnp.take(cs, hi, axis=axis) - jnp.take(cs, lo, axis=axis)
    shape = [1] * u.ndim
    shape[axis] = n
    count = (hi - lo).astype(jnp.float32).reshape(shape)
    return total / count


def _pool_branch(u, grid, pool_w, pool_scale):
    b, n, _ = u.shape
    uf = u.astype(jnp.float32)
    if grid:
        rows = n // GRID_W
        uf = uf.reshape(b, rows, GRID_W, D_POOL)
        axis = 2
    else:
        axis = 1
    groups = []
    for g, win in enumerate(POOL_WINDOWS):
        ch = uf[..., g * POOL_GROUP:(g + 1) * POOL_GROUP]
        groups.append(_centred_mean(ch, axis, win) - ch)
    pooled = jnp.stack(groups, axis=-2)
    mixed = jnp.einsum('...gi,gio->...go', pooled, pool_w)
    return mixed.reshape(b, n, D_POOL) * pool_scale


def _shift3(u, w):
    up = jnp.pad(u, ((0, 0), (1, 1), (0, 0)))
    return w[0] * up[:, :-2] + w[1] * up[:, 1:-1] + w[2] * up[:, 2:]


def _rwkv_dir_inputs(u, d, w0, w_up, a0, a_up, k_k, k_a):
    r = u[..., :D_RWKV]
    k = u[..., D_RWKV:2 * D_RWKV]
    v = u[..., 2 * D_RWKV:3 * D_RWKV]
    o = 3 * D_RWKV
    xw = u[..., o + d * LORA_W:o + (d + 1) * LORA_W]
    o2 = o + N_DIR * LORA_W
    xa = u[..., o2 + d * LORA_A:o2 + (d + 1) * LORA_A]
    w_log = -jax.nn.softplus(-(w0[d] + jnp.tanh(xw) @ w_up[d])) - 0.5
    decay = jnp.exp(-jnp.exp(w_log))
    a = jax.nn.sigmoid(a0[d] + xa @ a_up[d])
    kk = _heads(k * k_k)
    kk = kk * lax.rsqrt(jnp.sum(kk * kk, axis=-1, keepdims=True) + 1e-12)
    k_mod = k * (1.0 + (a - 1.0) * k_a)
    return (_heads(r), _heads(decay), _heads(k_mod), _heads(v), kk, _heads(a))


def _rwkv_bonus(ins, r_k_d):
    r, k_mod, v = ins[0], ins[2], ins[3]
    return jnp.sum(r * k_mod * r_k_d, axis=-1, keepdims=True) * v


def _rwkv_scan(state, ins, emit):
    r, w, k, v, kk, a = (jnp.moveaxis(z, 1, 0) for z in ins)
    xs = (w, k, v, kk, a, r) if emit else (w, k, v, kk, a)

    def step(S, inp):
        w_t, k_t, v_t, kk_t, a_t = inp[:5]
        sa = jnp.einsum('bhvk,bhk->bhv', S, kk_t)
        S = (S * w_t[:, :, None, :] - sa[..., None] * (kk_t * a_t)[:, :, None, :]
             + v_t[..., None] * k_t[:, :, None, :])
        y = jnp.einsum('bhvk,bhk->bhv', S, inp[5]) if emit else None
        return S, y

    state, ys = lax.scan(step, state, xs)
    return state, (jnp.moveaxis(ys, 0, 1) if emit else None)


def _rwkv_readout(y, bonus, gn_g, gn_b):
    mu = jnp.mean(y, axis=-1, keepdims=True)
    var = jnp.mean(jnp.square(y - mu), axis=-1, keepdims=True)
    yn = (y - mu) * lax.rsqrt(var + GN_EPS) * gn_g.reshape(H_RWKV, HEAD_DIM) + gn_b.reshape(H_RWKV, HEAD_DIM)
    out = yn + bonus
    return out.reshape(out.shape[:-2] + (D_RWKV,))


def _rwkv_branch(u_ctx, u_lat, w0, w_up, a0, a_up, k_k, k_a, r_k, gn_g, gn_b, emit_ctx):
    b = u_lat.shape[0]
    y_ctx, y_lat, bonus_ctx, bonus_lat = 0.0, 0.0, 0.0, 0.0
    for d in range(N_DIR):
        ins_c = _rwkv_dir_inputs(u_ctx, d, w0, w_up, a0, a_up, k_k, k_a)
        ins_l = _rwkv_dir_inputs(u_lat, d, w0, w_up, a0, a_up, k_k, k_a)
        bonus_lat = bonus_lat + _rwkv_bonus(ins_l, r_k[d])
        if emit_ctx:
            bonus_ctx = bonus_ctx + _rwkv_bonus(ins_c, r_k[d])
        if d == 1:
            ins_c = tuple(jnp.flip(z, axis=1) for z in ins_c)
            ins_l = tuple(jnp.flip(z, axis=1) for z in ins_l)
        s0 = jnp.zeros((b, H_RWKV, HEAD_DIM, HEAD_DIM), jnp.float32)
        s_c, yc = _rwkv_scan(s0, ins_c, emit_ctx)
        _, yl = _rwkv_scan(s_c, ins_l, True)
        if d == 1:
            yl = jnp.flip(yl, axis=1)
            if emit_ctx:
                yc = jnp.flip(yc, axis=1)
        y_lat = y_lat + yl
        if emit_ctx:
            y_ctx = y_ctx + yc
    out_lat = _rwkv_readout(y_lat, bonus_lat, gn_g, gn_b)
    out_ctx = _rwkv_readout(y_ctx, bonus_ctx, gn_g, gn_b) if emit_ctx else None
    return out_ctx, out_lat


def _hgrn_dir_inputs(fh, d, lb_d):
    q = fh[..., :D_HGRN]
    i = fh[..., D_HGRN:2 * D_HGRN]
    z = fh[..., (2 + d) * D_HGRN:(3 + d) * D_HGRN]
    logf = jnp.logaddexp(jnp.log(lb_d), jnp.log1p(-lb_d) + jax.nn.log_sigmoid(z))
    k = (1.0 - lb_d) * jax.nn.sigmoid(-z)
    return (_heads(k), _heads(i), _heads(logf), _heads(q))


def _hgrn_scan(state, ins, emit):
    k, i, logf, q = ins
    b, n, h, dk = k.shape
    nc = n // HGRN_CHUNK

    def chunks(z):
        return z.reshape(b, nc, HGRN_CHUNK, h, dk).transpose(1, 0, 3, 2, 4)

    causal = jnp.tril(jnp.ones((HGRN_CHUNK, HGRN_CHUNK), dtype=bool))[:, :, None]

    def step(S, inp):
        k_c, i_c, lf_c = inp[:3]
        g = jnp.cumsum(lf_c, axis=2)
        g_last = g[:, :, -1:, :]
        if emit:
            q_c = inp[3]
            inter = jnp.einsum('bhtk,bhkv->bhtv', q_c * jnp.exp(g), S)
            rel = jnp.exp(jnp.where(causal, g[:, :, :, None, :] - g[:, :, None, :, :], -jnp.inf))
            scores = jnp.einsum('bhtk,bhsk,bhtsk->bhts', q_c, k_c, rel)
            o = inter + jnp.einsum('bhts,bhsv->bhtv', scores, i_c)
        else:
            o = None
        S = (jnp.exp(g_last[:, :, 0, :])[..., None] * S
             + jnp.einsum('bhsk,bhsv->bhkv', k_c * jnp.exp(g_last - g), i_c))
        return S, o

    xs = (chunks(k), chunks(i), chunks(logf), chunks(q)) if emit else (chunks(k), chunks(i), chunks(logf))
    state, o = lax.scan(step, state, xs)
    if emit:
        o = o.transpose(1, 0, 3, 2, 4).reshape(b, n, h, dk)
    return state, o


def _rms_heads(o, norm_g):
    on = o * lax.rsqrt(jnp.mean(o * o, axis=-1, keepdims=True) + RMS_EPS) * norm_g.reshape(H_HGRN, HEAD_DIM)
    return on.reshape(on.shape[:-2] + (D_HGRN,))


def _hgrn_branch(fh_ctx, fh_lat, lb, norm_g, emit_ctx):
    b = fh_lat.shape[0]
    o_ctx, o_lat = 0.0, 0.0
    for d in range(N_DIR):
        ins_c = _hgrn_dir_inputs(fh_ctx, d, lb[d])
        ins_l = _hgrn_dir_inputs(fh_lat, d, lb[d])
        if d == 1:
            ins_c = tuple(jnp.flip(z, axis=1) for z in ins_c)
            ins_l = tuple(jnp.flip(z, axis=1) for z in ins_l)
        s0 = jnp.zeros((b, H_HGRN, HEAD_DIM, HEAD_DIM), jnp.float32)
        s_c, oc = _hgrn_scan(s0, ins_c, emit_ctx)
        _, ol = _hgrn_scan(s_c, ins_l, True)
        if d == 1:
            ol = jnp.flip(ol, axis=1)
            if emit_ctx:
                oc = jnp.flip(oc, axis=1)
        o_lat = o_lat + ol
        if emit_ctx:
            o_ctx = o_ctx + oc
    out_ctx = _rms_heads(o_ctx, norm_g) if emit_ctx else None
    return out_ctx, _rms_heads(o_lat, norm_g)


def setup_inputs(seed: int = 0) -> dict:
    key = jax.random.key(seed)
    ks = jax.random.split(key, 24)
    f32 = jnp.float32

    def nrm(k, shape, scale):
        return scale * jax.random.normal(k, shape, f32)

    return {
        "x": nrm(ks[0], (BATCH, SEQ, D_MODEL), 1.0),
        "c": nrm(ks[1], (BATCH, D_MODEL), 1.0),
        "ctx": nrm(ks[2], (BATCH, CTX_LEN, D_MODEL), 1.0),
        "c_ctx": nrm(ks[3], (D_MODEL,), 1.0),
        "mod_w": nrm(ks[4], (DEPTH, D_MODEL, 3 * D_MODEL), D_MODEL ** -0.5),
        "mod_b": nrm(ks[5], (DEPTH, 3 * D_MODEL), 0.02),
        "w_in": nrm(ks[6], (DEPTH, D_MODEL, D_IN), D_MODEL ** -0.5),
        "rwkv_shift": jnp.array([0.25, 0.5, 0.25], f32)[None, :, None] + nrm(ks[7], (DEPTH, 3, D_RWKV_IN), 0.05),
        "pool_w": nrm(ks[8], (DEPTH, N_POOL_GROUPS, POOL_GROUP, POOL_GROUP), POOL_GROUP ** -0.5),
        "pool_scale": 1.0 + nrm(ks[9], (DEPTH, D_POOL), 0.1),
        "rwkv_w0": jax.random.uniform(ks[10], (DEPTH, N_DIR, D_RWKV), f32, minval=-5.0, maxval=-0.5),
        "rwkv_w_up": nrm(ks[11], (DEPTH, N_DIR, LORA_W, D_RWKV), 0.5 * LORA_W ** -0.5),
        "rwkv_a0": nrm(ks[12], (DEPTH, N_DIR, D_RWKV), 0.1),
        "rwkv_a_up": nrm(ks[13], (DEPTH, N_DIR, LORA_A, D_RWKV), LORA_A ** -0.5),
        "rwkv_k_k": 0.85 + nrm(ks[14], (DEPTH, D_RWKV), 0.05),
        "rwkv_k_a": 1.0 + nrm(ks[15], (DEPTH, D_RWKV), 0.05),
        "rwkv_r_k": nrm(ks[16], (DEPTH, N_DIR, H_RWKV, HEAD_DIM), 0.1),
        "rwkv_gn_g": 1.0 + nrm(ks[17], (DEPTH, D_RWKV), 0.05),
        "rwkv_gn_b": nrm(ks[18], (DEPTH, D_RWKV), 0.02),
        "hgrn_lb_logits": nrm(ks[19], (N_DIR, DEPTH, D_HGRN), 0.5),
        "hgrn_norm_g": 1.0 + nrm(ks[20], (DEPTH, D_HGRN), 0.05),
        "w_out": nrm(ks[21], (DEPTH, D_MIX, D_MODEL), BETA * D_MIX ** -0.5),
        "ln_g": 1.0 + nrm(ks[22], (DEPTH, D_MODEL), 0.05),
        "ln_b": nrm(ks[23], (DEPTH, D_MODEL), 0.02),
    }


def reference(x, c, ctx, c_ctx, mod_w, mod_b, w_in, rwkv_shift, pool_w, pool_scale,
              rwkv_w0, rwkv_w_up, rwkv_a0, rwkv_a_up, rwkv_k_k, rwkv_k_a, rwkv_r_k,
              rwkv_gn_g, rwkv_gn_b, hgrn_lb_logits, hgrn_norm_g, w_out, ln_g, ln_b):
    out_dtype = x.dtype
    lb_w = jax.nn.softmax(hgrn_lb_logits.astype(jnp.float32), axis=1)
    lb_all = jnp.maximum(jnp.cumsum(lb_w, axis=1) - lb_w[:, :1], 0.0)
    h_x = x.astype(jnp.float32)
    h_ctx = ctx.astype(jnp.float32)
    for l in range(DEPTH):
        last = l == DEPTH - 1
        mod_lat = jax.nn.silu(c.astype(jnp.float32)) @ mod_w[l] + mod_b[l]
        mod_c = jax.nn.silu(c_ctx.astype(jnp.float32)) @ mod_w[l] + mod_b[l]
        sh_l, sc_l, gt_l = jnp.split(mod_lat, 3, axis=-1)
        sh_c, sc_c, gt_c = jnp.split(mod_c, 3, axis=-1)
        p_lat = (_layer_norm(h_x) * (1.0 + sc_l[:, None]) + sh_l[:, None]) @ w_in[l]
        p_ctx = (_layer_norm(h_ctx) * (1.0 + sc_c) + sh_c) @ w_in[l]
        pv_l, u_l, fh_l, g_l = _split_proj(p_lat)
        pv_c, u_c, fh_c, g_c = _split_proj(p_ctx)
        u_l = _shift3(u_l, rwkv_shift[l])
        u_c = _shift3(u_c, rwkv_shift[l])
        y_rc, y_rl = _rwkv_branch(u_c, u_l, rwkv_w0[l], rwkv_w_up[l], rwkv_a0[l], rwkv_a_up[l],
                                  rwkv_k_k[l], rwkv_k_a[l], rwkv_r_k[l], rwkv_gn_g[l], rwkv_gn_b[l],
                                  not last)
        o_hc, o_hl = _hgrn_branch(fh_c, fh_l, lb_all[:, l], hgrn_norm_g[l], not last)
        pool_l = _pool_branch(pv_l, True, pool_w[l], pool_scale[l])
        mix_l = jnp.concatenate([pool_l, y_rl, o_hl], axis=-1) * jax.nn.silu(g_l)
        new_x = _layer_norm(ALPHA * h_x + gt_l[:, None] * (mix_l @ w_out[l])) * ln_g[l] + ln_b[l]
        if not last:
            pool_c = _pool_branch(pv_c, False, pool_w[l], pool_scale[l])
            mix_c = jnp.concatenate([pool_c, y_rc, o_hc], axis=-1) * jax.nn.silu(g_c)
            h_ctx = _layer_norm(ALPHA * h_ctx + gt_c * (mix_c @ w_out[l])) * ln_g[l] + ln_b[l]
        h_x = new_x
    return h_x.astype(out_dtype)
```

```cpp
#include <hip/hip_runtime.h>
#include <hip/hip_bf16.h>
#include <hip/hip_cooperative_groups.h>
#include <cstdio>
namespace cg = cooperative_groups;

typedef unsigned short bf16_t;
using bf16x8 = __attribute__((ext_vector_type(8))) short;
using f32x4 = __attribute__((ext_vector_type(4))) float;
using u32x4 = __attribute__((ext_vector_type(4))) unsigned;

#define DM 1024
#define NB 16
#define SEQL 2048
#define CTXL 256
#define NLAT 32768
#define NCTX 4096
#define NTOK 36864
#define DIN 4224
#define ALPHA_F 1.4142135623730951f
#define LN_EPS_F 1e-5f
#define GN_EPS_F 64e-5f
#define RMS_EPS_F 1e-6f
#define YREC 1536
#define PTOFF(col) ((((col) >> 7) * NTOK) * 128 + ((col) & 127))
#define PT(tok, col) ((size_t)PTOFF(col) + (size_t)(tok) * 128)
#define XT(row, k) ((size_t)(((k) >> 6) * NTOK + (row)) * 64 + ((k) & 63))
#define SMEM_BYTES 65536
#ifndef REP_P0
#define REP_P0 1
#endif
#ifndef REP_LN
#define REP_LN 1
#endif
#ifndef REP_G1
#define REP_G1 1
#endif
#ifndef REP_SCAN
#define REP_SCAN 1
#endif
#ifndef REP_MIX
#define REP_MIX 1
#endif
#ifndef REP_G2
#define REP_G2 1
#endif

struct Params {
  const float *x, *c, *ctx, *c_ctx, *mod_w, *mod_b, *w_in, *rwkv_shift, *pool_w, *pool_scale,
      *rwkv_w0, *rwkv_w_up, *rwkv_a0, *rwkv_a_up, *rwkv_k_k, *rwkv_k_a, *rwkv_r_k, *rwkv_gn_g, *rwkv_gn_b,
      *hgrn_lb, *hgrn_norm_g, *w_out, *ln_g, *ln_b;
  float* out;
  bf16_t *WtIn, *WtOut, *xn, *p, *yrec;
  float *mod, *bonus, *hprectx;
  bf16_t* loraT;
  char* ring;
  unsigned* bar;
};

__device__ __forceinline__ float bf2f(bf16_t v) { return __uint_as_float(((unsigned)v) << 16); }
__device__ __forceinline__ bf16_t f2bf(float f) {
  unsigned u = __float_as_uint(f);
  u += 0x7fffu + ((u >> 16) & 1u);
  return (bf16_t)(u >> 16);
}
#define DPPF(v, ctrl) __builtin_bit_cast(float, __builtin_amdgcn_update_dpp(0, __builtin_bit_cast(int, (v)), (ctrl), 0xf, 0xf, true))
__device__ __forceinline__ float rsum16(float v) {
  v += DPPF(v, 0xB1);
  v += DPPF(v, 0x4E);
  v += DPPF(v, 0x141);
  v += DPPF(v, 0x140);
  return v;
}
__device__ __forceinline__ float wsum(float v) {
  v = rsum16(v);
  int iv = __builtin_bit_cast(int, v);
  float a = __builtin_bit_cast(float, __builtin_amdgcn_readlane(iv, 0));
  float b = __builtin_bit_cast(float, __builtin_amdgcn_readlane(iv, 16));
  float c = __builtin_bit_cast(float, __builtin_amdgcn_readlane(iv, 32));
  float d = __builtin_bit_cast(float, __builtin_amdgcn_readlane(iv, 48));
  return (a + b) + (c + d);
}
__device__ __forceinline__ int opq(int v) { asm volatile("" : "+v"(v)); return v; }
__device__ __forceinline__ float frcp(float x) { return __builtin_amdgcn_rcpf(x); }
__device__ __forceinline__ float siluf(float x) { return x * frcp(1.f + __expf(-x)); }
__device__ __forceinline__ float sigmf(float x) { return frcp(1.f + __expf(-x)); }
__device__ __forceinline__ float ftanh(float x) { return 1.f - 2.f * frcp(1.f + __expf(2.f * x)); }

__device__ void transpose_tile(const float* __restrict__ W, int N, bf16_t* __restrict__ Wt, int kt, int nt, float* sm) {
  int tid = opq(threadIdx.x);
  {
    float vals[16];
#pragma unroll
    for (int k = 0; k < 16; ++k) {
      int e = tid + k * 256;
      int kk = e >> 6, nn = e & 63;
      vals[k] = W[(size_t)(kt * 64 + kk) * N + nt * 64 + nn];
    }
#pragma unroll
    for (int k = 0; k < 16; ++k) {
      int e = tid + k * 256;
      sm[(e >> 6) * 65 + (e & 63)] = vals[k];
    }
  }
  __syncthreads();
  for (int e = tid; e < 4096; e += 256) {
    int nn = e >> 6, kk = e & 63;
    Wt[((size_t)kt * N + nt * 64 + nn) * 64 + kk] = f2bf(sm[kk * 65 + nn]);
  }
  __syncthreads();
}

__device__ void mod_unit(const Params& P, int l, int cb, float* sm) {
  int tid = opq(threadIdx.x), j = tid & 15, kp = tid >> 4;
  float acc[17];
#pragma unroll
  for (int r = 0; r < 17; ++r) acc[r] = 0.f;
  const float* W = P.mod_w + (size_t)l * 1024 * 3072 + cb * 16 + j;
  for (int pass = 0; pass < 2; ++pass) {
    for (int e = tid; e < 17 * 512; e += 256) {
      int r = e >> 9, k = (e & 511) + pass * 512;
      float v = (r < 16) ? P.c[r * 1024 + k] : P.c_ctx[k];
      sm[e] = siluf(v);
    }
    __syncthreads();
    {
      const int k0 = kp * 32;
      float wv[32];
#pragma unroll
      for (int u = 0; u < 32; ++u) wv[u] = W[(size_t)(pass * 512 + k0 + u) * 3072];
#pragma unroll
      for (int u = 0; u < 32; ++u) {
#pragma unroll
        for (int r = 0; r < 17; ++r) acc[r] += sm[r * 512 + k0 + u] * wv[u];
      }
    }
    __syncthreads();
  }
#pragma unroll
  for (int r = 0; r < 17; ++r) sm[(kp * 17 + r) * 16 + j] = acc[r];
  __syncthreads();
  for (int e = tid; e < 17 * 16; e += 256) {
    int r = e >> 4, jj = e & 15;
    float s0 = 0.f;
#pragma unroll
    for (int k = 0; k < 16; ++k) s0 += sm[(k * 17 + r) * 16 + jj];
    int col = cb * 16 + jj;
    P.mod[((size_t)l * 17 + r) * 3072 + col] = s0 + P.mod_b[l * 3072 + col];
  }
  __syncthreads();
}

__device__ __forceinline__ void ln16(float (&v)[16]) {
  float s = 0.f;
#pragma unroll
  for (int i = 0; i < 16; ++i) s += v[i];
  float mu = wsum(s) * (1.f / 1024.f);
  float q = 0.f;
#pragma unroll
  for (int i = 0; i < 16; ++i) { v[i] -= mu; q += v[i] * v[i]; }
  float rs = rsqrtf(wsum(q) * (1.f / 1024.f) + LN_EPS_F);
#pragma unroll
  for (int i = 0; i < 16; ++i) v[i] *= rs;
}

__device__ void ln_phase(const Params& P, int l) {
  const int tidq = opq(threadIdx.x);
  int lane = tidq & 63;
  int gw = (blockIdx.x * 256 + tidq) >> 6, nw = (gridDim.x * 256) >> 6;
#pragma unroll 2
  for (int row = gw; row < NTOK; row += nw) {
    const float* src;
    int r;
    if (row < NLAT) { src = (l == 0 ? P.x : P.out) + (size_t)row * 1024; r = row >> 11; }
    else { src = (l == 0 ? P.ctx : P.hprectx) + (size_t)(row - NLAT) * 1024; r = 16; }
    float v[16];
#pragma unroll
    for (int i = 0; i < 4; ++i) {
      float4 t = *(const float4*)(src + i * 256 + lane * 4);
      v[i * 4] = t.x; v[i * 4 + 1] = t.y; v[i * 4 + 2] = t.z; v[i * 4 + 3] = t.w;
    }
    if (l > 0) {
      ln16(v);
#pragma unroll
      for (int i = 0; i < 4; ++i) {
        float4 g = *(const float4*)(P.ln_g + (l - 1) * 1024 + i * 256 + lane * 4);
        float4 bb = *(const float4*)(P.ln_b + (l - 1) * 1024 + i * 256 + lane * 4);
        v[i * 4] = v[i * 4] * g.x + bb.x; v[i * 4 + 1] = v[i * 4 + 1] * g.y + bb.y;
        v[i * 4 + 2] = v[i * 4 + 2] * g.z + bb.z; v[i * 4 + 3] = v[i * 4 + 3] * g.w + bb.w;
      }
      if (row < NLAT) {
#pragma unroll
        for (int i = 0; i < 4; ++i)
          *(float4*)(P.out + (size_t)row * 1024 + i * 256 + lane * 4) = make_float4(v[i * 4], v[i * 4 + 1], v[i * 4 + 2], v[i * 4 + 3]);
      }
    }
    ln16(v);
    const float* md = P.mod + ((size_t)l * 17 + r) * 3072;
#pragma unroll
    for (int i = 0; i < 4; ++i) {
      float4 sh = *(const float4*)(md + i * 256 + lane * 4);
      float4 sc = *(const float4*)(md + 1024 + i * 256 + lane * 4);
      ushort4 o;
      o.x = f2bf(v[i * 4] * (1.f + sc.x) + sh.x);
      o.y = f2bf(v[i * 4 + 1] * (1.f + sc.y) + sh.y);
      o.z = f2bf(v[i * 4 + 2] * (1.f + sc.z) + sh.z);
      o.w = f2bf(v[i * 4 + 3] * (1.f + sc.w) + sh.w);
      *(ushort4*)(P.xn + XT(row, i * 256 + lane * 4)) = o;
    }
  }
}

__device__ void final_ln_phase(const Params& P) {
  const int tidq = opq(threadIdx.x);
  int lane = tidq & 63;
  int gw = (blockIdx.x * 256 + tidq) >> 6, nw = (gridDim.x * 256) >> 6;
  for (int row = gw; row < NLAT; row += nw) {
    float* src = P.out + (size_t)row * 1024;
    float v[16];
#pragma unroll
    for (int i = 0; i < 4; ++i) {
      float4 t = *(const float4*)(src + i * 256 + lane * 4);
      v[i * 4] = t.x; v[i * 4 + 1] = t.y; v[i * 4 + 2] = t.z; v[i * 4 + 3] = t.w;
    }
    ln16(v);
#pragma unroll
    for (int i = 0; i < 4; ++i) {
      float4 g = *(const float4*)(P.ln_g + 1024 + i * 256 + lane * 4);
      float4 bb = *(const float4*)(P.ln_b + 1024 + i * 256 + lane * 4);
      *(float4*)(src + i * 256 + lane * 4) = make_float4(v[i * 4] * g.x + bb.x, v[i * 4 + 1] * g.y + bb.y,
                                                          v[i * 4 + 2] * g.z + bb.z, v[i * 4 + 3] * g.w + bb.w);
    }
  }
}

typedef __bf16 bf2e_t __attribute__((ext_vector_type(2)));
typedef float fl2e_t __attribute__((ext_vector_type(2)));
__device__ __forceinline__ unsigned pk2(float a, float b) {
  fl2e_t f = {a, b};
  bf2e_t h = __builtin_convertvector(f, bf2e_t);
  return __builtin_bit_cast(unsigned, h);
}
template <int MODE>
__device__ void gemm_tile(const Params& P, int l, const bf16_t* __restrict__ A, const bf16_t* __restrict__ Bt,
                          int row0, int col0, char* smem) {
  const int tid = opq(threadIdx.x), lane = tid & 63, wave = tid >> 6, wr = wave >> 1, wc = wave & 1, fr = lane & 15, fq = lane >> 4;
  f32x4 acc[4][4];
#pragma unroll
  for (int m = 0; m < 4; ++m)
#pragma unroll
    for (int n = 0; n < 4; ++n) acc[m][n] = f32x4{0.f, 0.f, 0.f, 0.f};
  u32x4 ra0[4], rb0[4], ra1[4], rb1[4];
  const int crow = tid >> 3, c16 = tid & 7;
  const int NBR = (MODE == 0) ? DIN : 1024;
  const bf16_t* Ag = A + (size_t)(row0 + crow) * 64 + c16 * 8;
  const bf16_t* Bg = Bt + (size_t)(col0 + crow) * 64 + c16 * 8;
#define GLOAD(RA, RB, kt)                                                                           \
  _Pragma("unroll") for (int i = 0; i < 4; ++i) {                                                   \
    asm volatile("global_load_dwordx4 %0, %1, off" : "=v"(RA[i]) : "v"(Ag + (size_t)i * 32 * 64 + (size_t)(kt) * NTOK * 64)); \
    asm volatile("global_load_dwordx4 %0, %1, off" : "=v"(RB[i]) : "v"(Bg + (size_t)i * 32 * 64 + (size_t)(kt) * NBR * 64)); \
  }
#define LSTORE(RA, RB, s)                                                                  \
  _Pragma("unroll") for (int i = 0; i < 4; ++i) {                                          \
    *(u32x4*)(smem + (s) * 32768 + (crow + i * 32) * 128 + ((c16 ^ (((crow + i * 32) >> 1) & 7)) << 4)) = RA[i];          \
    *(u32x4*)(smem + (s) * 32768 + 16384 + (crow + i * 32) * 128 + ((c16 ^ (((crow + i * 32) >> 1) & 7)) << 4)) = RB[i];  \
  }
#define COMPUTE(s)                                                                                                   \
  {                                                                                                                  \
    const char* sA = smem + (s) * 32768;                                                                             \
    const char* sB = sA + 16384;                                                                                     \
    bf16x8 af0[4], bf0[4], af1[4], bf1[4];                                                                           \
    _Pragma("unroll") for (int m = 0; m < 4; ++m)                                                                    \
      af0[m] = *(const bf16x8*)(sA + (wr * 64 + m * 16 + fr) * 128 + (((0 + fq) ^ ((fr >> 1) & 7)) << 4));           \
    _Pragma("unroll") for (int n = 0; n < 4; ++n)                                                                    \
      bf0[n] = *(const bf16x8*)(sB + (wc * 64 + n * 16 + fr) * 128 + (((0 + fq) ^ ((fr >> 1) & 7)) << 4));           \
    _Pragma("unroll") for (int m = 0; m < 4; ++m)                                                                    \
      af1[m] = *(const bf16x8*)(sA + (wr * 64 + m * 16 + fr) * 128 + (((4 + fq) ^ ((fr >> 1) & 7)) << 4));           \
    _Pragma("unroll") for (int n = 0; n < 4; ++n)                                                                    \
      bf1[n] = *(const bf16x8*)(sB + (wc * 64 + n * 16 + fr) * 128 + (((4 + fq) ^ ((fr >> 1) & 7)) << 4));           \
    __builtin_amdgcn_sched_barrier(0);                                                                               \
    __builtin_amdgcn_s_setprio(1);                                                                                   \
    _Pragma("unroll") for (int m = 0; m < 4; ++m)                                                                    \
      _Pragma("unroll") for (int n = 0; n < 4; ++n)                                                                  \
        acc[m][n] = __builtin_amdgcn_mfma_f32_16x16x32_bf16(bf0[n], af0[m], acc[m][n], 0, 0, 0);                     \
    _Pragma("unroll") for (int m = 0; m < 4; ++m)                                                                    \
      _Pragma("unroll") for (int n = 0; n < 4; ++n)                                                                  \
        acc[m][n] = __builtin_amdgcn_mfma_f32_16x16x32_bf16(bf1[n], af1[m], acc[m][n], 0, 0, 0);                     \
    __builtin_amdgcn_s_setprio(0);                                                                                   \
  }
  GLOAD(ra0, rb0, 0);
  asm volatile("s_waitcnt vmcnt(0)" ::: "memory");
  LSTORE(ra0, rb0, 0);
  GLOAD(ra0, rb0, 1);
  __syncthreads();
  for (int kt = 0; kt < 16; kt += 2) {
    if (kt + 2 < 16) { GLOAD(ra1, rb1, kt + 2); }
    __builtin_amdgcn_sched_barrier(0);
    COMPUTE(0);
    __builtin_amdgcn_sched_barrier(0);
    if (kt + 2 < 16) asm volatile("s_waitcnt vmcnt(8)" ::: "memory");
    else asm volatile("s_waitcnt vmcnt(0)" ::: "memory");
    LSTORE(ra0, rb0, 1);
    __syncthreads();
    if (kt + 3 < 16) { GLOAD(ra0, rb0, kt + 3); }
    __builtin_amdgcn_sched_barrier(0);
    COMPUTE(1);
    __builtin_amdgcn_sched_barrier(0);
    if (kt + 2 < 16) {
      if (kt + 3 < 16) asm volatile("s_waitcnt vmcnt(8)" ::: "memory");
      else asm volatile("s_waitcnt vmcnt(0)" ::: "memory");
      LSTORE(ra1, rb1, 0);
    }
    __syncthreads();
  }
#undef COMPUTE
#undef GLOAD
#undef LSTORE
#pragma unroll
  for (int m = 0; m < 4; ++m) {
    int row = row0 + wr * 64 + m * 16 + fr;
#pragma unroll
    for (int n = 0; n < 4; ++n) {
      int col = col0 + wc * 64 + n * 16 + fq * 4;
      if (MODE == 0) {
        uint2 o;
        o.x = pk2(acc[m][n][0], acc[m][n][1]); o.y = pk2(acc[m][n][2], acc[m][n][3]);
        *(uint2*)(smem + (row - row0) * 272 + (col - col0) * 2) = o;
      } else {
        const float* hsrc;
        float* dst;
        int r;
        if (row < NLAT) {
          hsrc = (l == 0 ? P.x : P.out) + (size_t)row * 1024 + col;
          dst = P.out + (size_t)row * 1024 + col;
          r = row >> 11;
        } else {
          hsrc = P.ctx + (size_t)(row - NLAT) * 1024 + col;
          dst = P.hprectx + (size_t)(row - NLAT) * 1024 + col;
          r = 16;
        }
        float4 hv = *(const float4*)hsrc;
        float4 gt = *(const float4*)(P.mod + ((size_t)l * 17 + r) * 3072 + 2048 + col);
        float4 o;
        o.x = ALPHA_F * hv.x + gt.x * acc[m][n][0];
        o.y = ALPHA_F * hv.y + gt.y * acc[m][n][1];
        o.z = ALPHA_F * hv.z + gt.z * acc[m][n][2];
        o.w = ALPHA_F * hv.w + gt.w * acc[m][n][3];
        *(float4*)dst = o;
      }
    }
  }
  if (MODE == 0) {
    __syncthreads();
#pragma unroll
    for (int i = 0; i < 8; ++i) {
      const int c = tid + 256 * i, rr = c >> 4, cc = c & 15;
      u32x4 v = *(const u32x4*)(smem + rr * 272 + cc * 16);
      *(u32x4*)(P.p + PT(row0 + rr, col0) + cc * 8) = v;
    }
    __syncthreads();
  }
}

typedef __bf16 bf2_t __attribute__((ext_vector_type(2)));
typedef float fl2_t __attribute__((ext_vector_type(2)));
using bf16x4 = __attribute__((ext_vector_type(4))) short;
__device__ __forceinline__ bf16_t f2bfh(float a) { return (bf16_t)(pk2(a, 0.f) & 0xffffu); }
__device__ __forceinline__ float rlane(float x, int l) {
  return __builtin_bit_cast(float, __builtin_amdgcn_readlane(__builtin_bit_cast(int, x), l));
}
__device__ __forceinline__ void wave_sync() {
  asm volatile("s_waitcnt lgkmcnt(0)" ::: "memory");
  __builtin_amdgcn_wave_barrier();
}
union U8 { bf16x8 v; unsigned u[4]; uint4 q; };
union U4 { bf16x4 v; unsigned u[2]; uint2 q; };
__device__ __forceinline__ bf16x8 pack8(f32x4 a, f32x4 b) {
  U8 r;
  r.u[0] = pk2(a[0], a[1]); r.u[1] = pk2(a[2], a[3]); r.u[2] = pk2(b[0], b[1]); r.u[3] = pk2(b[2], b[3]);
  return r.v;
}
__device__ __forceinline__ f32x4 unpack4(uint2 w) {
  f32x4 r;
  r[0] = __uint_as_float(w.x << 16); r[1] = __uint_as_float(w.x & 0xffff0000u);
  r[2] = __uint_as_float(w.y << 16); r[3] = __uint_as_float(w.y & 0xffff0000u);
  return r;
}
#define RSLOT 14592
using u32x2 = __attribute__((ext_vector_type(2))) unsigned;
#define GLD(T, p) (*(const __attribute__((address_space(1))) T*)(p))
#define GST(T, p, v) (*(__attribute__((address_space(1))) T*)(p) = (v))
#define MFMA32(a, b, c) __builtin_amdgcn_mfma_f32_16x16x32_bf16(a, b, c, 0, 0, 0)
#define MFMA16(a, b, c) __builtin_amdgcn_mfma_f32_16x16x16bf16_1k(a, b, c, 0, 0, 0)

__device__ void rwkv_unit2(const Params& P, int l, int b, int h, int d, char* smem, int unit) {
  const int tid = opq(threadIdx.x), lane0 = tid & 63, wave = __builtin_amdgcn_readfirstlane(tid >> 6);
  char* wsm = smem + wave * 16384;
  bf16_t* Q1 = (bf16_t*)wsm;
  bf16_t* Q2 = (bf16_t*)(wsm + 2048);
  bf16_t* Q3 = (bf16_t*)(wsm + 4096);
  bf16_t* Q4 = (bf16_t*)(wsm + 6144);
  float* F = (float*)(wsm + 8192);
  char* ring0 = P.ring + (size_t)unit * 4 * RSLOT;
  const bf16_t* WT = P.loraT + (size_t)((l * 2 + d) * 6 + h) * 4096;
  const bf16_t* AT = WT + (size_t)24 * 4096;
  const float w0j = P.rwkv_w0[(l * 2 + d) * 384 + h * 64 + lane0];
  const float a0j = P.rwkv_a0[(l * 2 + d) * 384 + h * 64 + lane0];
  const float kkj = P.rwkv_k_k[l * 384 + h * 64 + lane0];
  const float kaj = P.rwkv_k_a[l * 384 + h * 64 + lane0];
  const float rkj = P.rwkv_r_k[((l * 2 + d) * 6 + h) * 64 + lane0];
  f32x4 accS[4];
#pragma unroll
  for (int mt = 0; mt < 4; ++mt) accS[mt] = f32x4{0.f, 0.f, 0.f, 0.f};

  for (int rnd = 0; rnd < 36; ++rnd) {
    int L, base;
    if (rnd < 4) { L = CTXL; base = NLAT + b * CTXL; }
    else { L = SEQL; base = b * SEQL; }
    const int rr0 = (rnd < 4) ? rnd : rnd - 4;
    const int lane = opq(lane0), fr = lane & 15, q = lane >> 4, j = lane;
    const int offA = (j >> 5) * 1024 + ((j >> 2) & 3) * 256 + ((j >> 4) & 1) * 8 + (j & 3) * 2;
    char* ring = ring0;
    asm volatile("" : "+s"(ring));
    char* myslot = ring + wave * RSLOT;
    {
      const int spos = (rr0 * 4 + wave) * 16;
      const int t0 = d ? (L - 1 - spos) : spos;
      const int tlo = d ? (t0 - 15) : t0;
      float rv[16], kv[16], vv[16];
      {
        __amdgpu_buffer_rsrc_t prs = __builtin_amdgcn_make_buffer_rsrc((void*)P.p, 0, 0x7ffffff0, 0x00020000);
        int uc_[5];
        uc_[0] = 1152 + d * 64; uc_[1] = 1280 + d * 64; uc_[2] = h * 64; uc_[3] = 384 + h * 64; uc_[4] = 768 + h * 64;
        const bool vprev = d ? (t0 < L - 1) : (t0 > 0);
        const bool vnext = d ? (t0 - 15 > 0) : (t0 + 15 < L - 1);
        const int tmin = d ? (t0 - 16) : (t0 - 1);
        char* stg = wsm + 4096;
        const int lrow = opq(lane) >> 3, lc8 = lane & 7;
        u32x4 pcs[5][3];
#pragma unroll
        for (int g = 0; g < 5; ++g) {
          const int so = __builtin_amdgcn_readfirstlane((PTOFF(256 + uc_[g]) + (base + tmin) * 128) * 2);
#pragma unroll
          for (int k = 0; k < 3; ++k) {
            const int rr = lrow + 8 * k;
            const int ridx = d ? (17 - rr) : rr;
            pcs[g][k] = u32x4{0u, 0u, 0u, 0u};
            const bool ok = (rr < 18) && !((rr == 0) && !vprev) && !((rr == 17) && !vnext);
            if (ok) pcs[g][k] = __builtin_amdgcn_raw_buffer_load_b128(prs, ridx * 256 + lc8 * 16, so, 0);
          }
        }
#pragma unroll
        for (int g = 0; g < 5; ++g)
#pragma unroll
          for (int k = 0; k < 3; ++k) {
            const int rr = lrow + 8 * k;
            if (rr < 18) *(u32x4*)(stg + (g * 18 + rr) * 128 + lc8 * 16) = pcs[g][k];
          }
        wave_sync();
        bf16_t raw[5][18];
#pragma unroll
        for (int g = 0; g < 5; ++g)
#pragma unroll
          for (int rr = 0; rr < 18; ++rr) raw[g][rr] = *(const bf16_t*)(stg + (g * 18 + rr) * 128 + j * 2);
        wave_sync();
        __builtin_amdgcn_sched_barrier(0);
#pragma unroll
        for (int g = 0; g < 5; ++g) {
          const int uc = uc_[g] + j;
          const float ca = P.rwkv_shift[(l * 3 + 0) * 1408 + uc], c1 = P.rwkv_shift[(l * 3 + 1) * 1408 + uc],
                      cb = P.rwkv_shift[(l * 3 + 2) * 1408 + uc];
          const float cprev = d ? cb : ca, cnext = d ? ca : cb;
#pragma unroll
          for (int i = 0; i < 16; ++i) {
            float val = cprev * bf2f(raw[g][i]) + c1 * bf2f(raw[g][i + 1]) + cnext * bf2f(raw[g][i + 2]);
            if (g == 0) Q1[i * 64 + j] = f2bfh(ftanh(val));
            else if (g == 1) Q2[i * 64 + j] = f2bfh(val);
            else if (g == 2) rv[i] = val;
            else if (g == 3) kv[i] = val;
            else vv[i] = val;
          }
        }
      }
      wave_sync();
      float* G = F + 1024;
#pragma unroll
      for (int nt = 0; nt < 4; ++nt) {
        f32x4 acc = {0.f, 0.f, 0.f, 0.f}, acc2 = acc;
#pragma unroll
        for (int s = 0; s < 2; ++s) {
          bf16x8 a = *(const bf16x8*)(Q1 + fr * 64 + s * 32 + q * 8);
          bf16x8 bw = *(const bf16x8*)(WT + (16 * nt + fr) * 64 + s * 32 + q * 8);
          acc = MFMA32(a, bw, acc);
          bf16x8 a2 = *(const bf16x8*)(Q2 + fr * 64 + s * 32 + q * 8);
          bf16x8 bw2 = *(const bf16x8*)(AT + (16 * nt + fr) * 64 + s * 32 + q * 8);
          acc2 = MFMA32(a2, bw2, acc2);
        }
#pragma unroll
        for (int jj = 0; jj < 4; ++jj) {
          F[(4 * q + jj) * 64 + 16 * nt + fr] = acc[jj];
          G[(4 * q + jj) * 64 + 16 * nt + fr] = acc2[jj];
        }
      }
      wave_sync();
      float kt[16];
      float khv[16], bhv[16];
      {
        float av[16], ssv[16];
        {
          float* R1 = (float*)Q1;
          float* R2 = (float*)Q3;
          float sq[16], bt[16];
#pragma unroll
          for (int i = 0; i < 16; ++i) {
            float a = sigmf(G[i * 64 + j] + a0j);
            av[i] = a;
            float kkv = kv[i] * kkj;
            sq[i] = kkv * kkv;
            bt[i] = rv[i] * (kv[i] * (1.f + (a - 1.f) * kaj)) * rkj;
          }
#pragma unroll
          for (int c4 = 0; c4 < 4; ++c4) {
            *(f32x4*)(R2 + j * 16 + c4 * 4) = f32x4{sq[c4 * 4], sq[c4 * 4 + 1], sq[c4 * 4 + 2], sq[c4 * 4 + 3]};
            *(f32x4*)(R1 + j * 16 + c4 * 4) = f32x4{bt[c4 * 4], bt[c4 * 4 + 1], bt[c4 * 4 + 2], bt[c4 * 4 + 3]};
          }
          wave_sync();
          float s1 = 0.f, s2 = 0.f;
#pragma unroll
          for (int k = 0; k < 16; ++k) {
            s1 += R2[(q * 16 + k) * 16 + fr];
            s2 += R1[(q * 16 + k) * 16 + fr];
          }
          s1 += __shfl_xor(s1, 16); s1 += __shfl_xor(s1, 32);
          s2 += __shfl_xor(s2, 16); s2 += __shfl_xor(s2, 32);
          if (lane < 16) {
            G[lane] = s1;
            const int tb = d ? (t0 - lane) : (t0 + lane);
            P.bonus[(size_t)(base + tb) * 12 + d * 6 + h] = s2;
          }
          wave_sync();
#pragma unroll
          for (int c4 = 0; c4 < 4; ++c4) {
            f32x4 x = *(const f32x4*)(G + c4 * 4);
            ssv[c4 * 4] = x[0]; ssv[c4 * 4 + 1] = x[1]; ssv[c4 * 4 + 2] = x[2]; ssv[c4 * 4 + 3] = x[3];
          }
          wave_sync();
        }
        float g = 0.f, eg = 1.f;
#pragma unroll
        for (int i = 0; i < 16; ++i) {
          float wl = F[i * 64 + j] + w0j;
          float lw = -0.60653066f * frcp(1.f + __expf(-wl));
          const float egp = eg;
          g += lw;
          float a = av[i];
          float kkv = kv[i] * kkj;
          float kk = kkv * __builtin_amdgcn_rsqf(ssv[i] + 1e-12f);
          float kmod = kv[i] * (1.f + (a - 1.f) * kaj);
          float bb = a * kk;
          eg = __expf(g);
          float eng = frcp(eg);
          kt[i] = kk * egp;
          khv[i] = kmod * eng;
          bhv[i] = bb * eng;
          Q1[i * 64 + j] = f2bfh(kt[i]);
          Q2[i * 64 + j] = f2bfh(rv[i] * eg);
          Q3[i * 64 + j] = f2bfh(bhv[i]);
          Q4[i * 64 + j] = f2bfh(khv[i]);
        }
        const float pC = eg;
        GST(float, myslot + 14336 + j * 4, pC);
#pragma unroll
        for (int qq = 0; qq < 4; ++qq) {
          uint4 o;
          o.x = pk2(khv[4 * qq] * pC, khv[4 * qq + 1] * pC);
          o.y = pk2(khv[4 * qq + 2] * pC, khv[4 * qq + 3] * pC);
          o.z = pk2(-bhv[4 * qq] * pC, -bhv[4 * qq + 1] * pC);
          o.w = pk2(-bhv[4 * qq + 2] * pC, -bhv[4 * qq + 3] * pC);
          GST(u32x4, myslot + 4096 + ((q * 64 + qq * 16 + fr) * 16), (u32x4{o.x, o.y, o.z, o.w}));
          uint2 ov;
          ov.x = pk2(vv[4 * qq], vv[4 * qq + 1]);
          ov.y = pk2(vv[4 * qq + 2], vv[4 * qq + 3]);
          GST(u32x2, myslot + 8192 + ((q * 64 + qq * 16 + fr) * 8), (u32x2{ov.x, ov.y}));
        }
        {
          uint4 o0, o1;
          o0.x = pk2(kt[0], kt[1]); o0.y = pk2(kt[2], kt[3]); o0.z = pk2(kt[4], kt[5]); o0.w = pk2(kt[6], kt[7]);
          o1.x = pk2(kt[8], kt[9]); o1.y = pk2(kt[10], kt[11]); o1.z = pk2(kt[12], kt[13]); o1.w = pk2(kt[14], kt[15]);
          *(uint4*)((char*)G + j * 32) = o0;
          *(uint4*)((char*)G + j * 32 + 16) = o1;
          o0.x = pk2(vv[0], vv[1]); o0.y = pk2(vv[2], vv[3]); o0.z = pk2(vv[4], vv[5]); o0.w = pk2(vv[6], vv[7]);
          o1.x = pk2(vv[8], vv[9]); o1.y = pk2(vv[10], vv[11]); o1.z = pk2(vv[12], vv[13]); o1.w = pk2(vv[14], vv[15]);
          *(uint4*)((char*)G + 2048 + j * 32) = o0;
          *(uint4*)((char*)G + 2048 + j * 32 + 16) = o1;
        }
      }
      wave_sync();
      f32x4 aM = {0.f, 0.f, 0.f, 0.f}, aN = aM, aRb = aM, aRk = aM;
#pragma unroll
      for (int s = 0; s < 2; ++s) {
        bf16x8 x1 = *(const bf16x8*)(Q1 + fr * 64 + s * 32 + q * 8);
        bf16x8 x2 = *(const bf16x8*)(Q2 + fr * 64 + s * 32 + q * 8);
        bf16x8 x3 = *(const bf16x8*)(Q3 + fr * 64 + s * 32 + q * 8);
        bf16x8 x4 = *(const bf16x8*)(Q4 + fr * 64 + s * 32 + q * 8);
        aM = MFMA32(x3, x1, aM);
        aN = MFMA32(x4, x1, aN);
        aRb = MFMA32(x3, x2, aRb);
        aRk = MFMA32(x4, x2, aRk);
      }
#pragma unroll
      for (int jj = 0; jj < 4; ++jj) {
        const int ii = 4 * q + jj;
        if (!(ii < fr)) { aM[jj] = 0.f; aN[jj] = 0.f; }
        if (!(ii <= fr)) { aRb[jj] = 0.f; aRk[jj] = 0.f; }
      }
      {
        const int c = lane & 15;
        float tt[16];
#pragma unroll
        for (int t = 0; t < 16; ++t) {
          float acc = (t == c) ? 1.f : 0.f;
#pragma unroll
          for (int i = 0; i < t; ++i) acc -= rlane(aM[i & 3], (i >> 2) * 16 + t) * tt[i];
          tt[t] = acc;
        }
        if (lane < 16) {
#pragma unroll
          for (int t = 0; t < 16; ++t) F[t * 16 + c] = tt[t];
        }
      }
      wave_sync();
      {
        U4 tA, nA, rbA, rkA;
        f32x4 tv = *(const f32x4*)(F + fr * 16 + 4 * q);
        tA.u[0] = pk2(tv[0], tv[1]); tA.u[1] = pk2(tv[2], tv[3]);
        nA.u[0] = pk2(aN[0], aN[1]); nA.u[1] = pk2(aN[2], aN[3]);
        rbA.u[0] = pk2(-aRb[0], -aRb[1]); rbA.u[1] = pk2(-aRb[2], -aRb[3]);
        rkA.u[0] = pk2(aRk[0], aRk[1]); rkA.u[1] = pk2(aRk[2], aRk[3]);
        const f32x4 z4 = {0.f, 0.f, 0.f, 0.f};
#pragma unroll
        for (int nt = 0; nt < 4; ++nt) {
          U4 kB, vB;
          kB.q = *(const uint2*)((const char*)G + (16 * nt + fr) * 32 + 8 * q);
          vB.q = *(const uint2*)((const char*)G + 2048 + (16 * nt + fr) * 32 + 8 * q);
          f32x4 kbar = MFMA16(tA.v, kB.v, z4);
          U4 kbB; kbB.u[0] = pk2(kbar[0], kbar[1]); kbB.u[1] = pk2(kbar[2], kbar[3]);
          f32x4 rtd;
#pragma unroll
          for (int jj = 0; jj < 4; ++jj) rtd[jj] = bf2f(Q2[(4 * q + jj) * 64 + 16 * nt + fr]);
          f32x4 rp = MFMA16(rbA.v, kbB.v, rtd);
          f32x4 nv = MFMA16(nA.v, vB.v, z4);
          U4 nvB; nvB.u[0] = pk2(nv[0], nv[1]); nvB.u[1] = pk2(nv[2], nv[3]);
          f32x4 w2 = MFMA16(tA.v, nvB.v, z4);
          U4 w2B; w2B.u[0] = pk2(w2[0], w2[1]); w2B.u[1] = pk2(w2[2], w2[3]);
          f32x4 yi = MFMA16(rkA.v, vB.v, z4);
          yi = MFMA16(rbA.v, w2B.v, yi);
          const int chan = 16 * nt + fr;
          const int oA = (chan >> 5) * 1024 + ((chan >> 2) & 3) * 256 + ((chan >> 4) & 1) * 8 + (chan & 3) * 2;
#pragma unroll
          for (int jj = 0; jj < 4; ++jj) {
            GST(bf16_t, myslot + oA + (4 * q + jj) * 16, f2bfh(kbar[jj]));
            GST(bf16_t, myslot + 2048 + oA + (4 * q + jj) * 16, f2bfh(rp[jj]));
          }
          GST(u32x2, myslot + 10240 + ((nt * 64 + lane) * 8), (u32x2{w2B.u[0], w2B.u[1]}));
          uint2 yo; yo.x = pk2(yi[0], yi[1]); yo.y = pk2(yi[2], yi[3]);
          GST(u32x2, myslot + 12288 + ((nt * 64 + lane) * 8), (u32x2{yo.x, yo.y}));
        }
      }
    }
    __syncthreads();
    unsigned pfd[2] = {0u, 0u};
    {
      {
        int nr = rnd + 1;
        if (nr < 36) {
          int Ln, basen;
          if (nr < 4) { Ln = CTXL; basen = NLAT + b * CTXL; }
          else { Ln = SEQL; basen = b * SEQL; }
          const int rrn = (nr < 4) ? nr : nr - 4;
          const int sposn = (rrn * 4 + wave) * 16;
          const int t0n = d ? (Ln - 1 - sposn) : sposn;
          const int tlon = d ? (t0n - 15) : t0n;
#pragma unroll
          for (int hlf = 0; hlf < 2; ++hlf) {
            int idx = lane + hlf * 64;
            if (idx < 90) {
              int ga = idx / 18, rr = idx % 18;
              int trow = tlon - 1 + rr;
              int col = (ga == 0) ? (h * 64) : (ga == 1) ? (384 + h * 64) : (ga == 2) ? (768 + h * 64) : (ga == 3) ? (1152 + d * 64) : (1280 + d * 64);
              if (trow >= 0 && trow < Ln) {
                asm volatile("global_load_ubyte %0, %1, off" : "=v"(pfd[hlf]) : "v"(P.p + PT(basen + trow, 256 + col)));
              }
            }
          }
        }
      }
      struct SeqOps { bf16x8 ka0, ka1, ra0, ra1, kb[4]; f32x4 pc[4]; u32x2 vq, w2q, yiq; };
      SeqOps cur, nxt;
#define LOADOPS(O, sc_)                                                          \
  {                                                                               \
    const char* sl = ring + (sc_) * RSLOT;                                        \
    O.ka0 = GLD(bf16x8, sl + lane * 16);                                     \
    O.ka1 = GLD(bf16x8, sl + 1024 + lane * 16);                              \
    O.ra0 = GLD(bf16x8, sl + 2048 + lane * 16);                              \
    O.ra1 = GLD(bf16x8, sl + 3072 + lane * 16);                              \
    _Pragma("unroll") for (int mt = 0; mt < 4; ++mt) {                            \
      O.kb[mt] = GLD(bf16x8, sl + 4096 + (mt * 64 + lane) * 16);             \
      O.pc[mt] = GLD(f32x4, sl + 14336 + (16 * mt + 4 * q) * 4);             \
    }                                                                             \
    O.vq = GLD(u32x2, sl + 8192 + (wave * 64 + lane) * 8);                   \
    O.w2q = GLD(u32x2, sl + 10240 + (wave * 64 + lane) * 8);                 \
    O.yiq = GLD(u32x2, sl + 12288 + (wave * 64 + lane) * 8);                 \
  }
      LOADOPS(cur, 0);
#pragma unroll
      for (int sc = 0; sc < 4; ++sc) {
        if (sc < 3) LOADOPS(nxt, sc + 1);
        bf16x8 B0 = pack8(accS[0], accS[1]);
        bf16x8 B1 = pack8(accS[2], accS[3]);
        f32x4 accU = unpack4(make_uint2(cur.w2q.x, cur.w2q.y));
        accU = MFMA32(cur.ka0, B0, accU);
        accU = MFMA32(cur.ka1, B1, accU);
        f32x4 accY = unpack4(make_uint2(cur.yiq.x, cur.yiq.y));
        accY = MFMA32(cur.ra0, B0, accY);
        accY = MFMA32(cur.ra1, B1, accY);
        U8 z;
        z.u[0] = cur.vq.x; z.u[1] = cur.vq.y;
        z.u[2] = pk2(accU[0], accU[1]); z.u[3] = pk2(accU[2], accU[3]);
#pragma unroll
        for (int mt = 0; mt < 4; ++mt) {
          f32x4 c = accS[mt] * cur.pc[mt];
          accS[mt] = MFMA32(cur.kb[mt], z.v, c);
        }
        const int spos = (rr0 * 4 + sc) * 16;
#pragma unroll
        for (int jj = 0; jj < 4; ++jj) {
          int s = spos + 4 * q + jj;
          int t = d ? (L - 1 - s) : s;
          P.yrec[(size_t)(base + t) * YREC + d * 384 + h * 64 + 16 * wave + fr] = f2bfh(accY[jj]);
        }
        if (sc < 3) cur = nxt;
      }
#undef LOADOPS
    }
    __syncthreads();
    asm volatile("" ::"v"(pfd[0]), "v"(pfd[1]));
  }
}

#define HSLOT 8448
__device__ void hgrn_unit2(const Params& P, int l, int b, int h, int d, char* smem) {
  const int tid = opq(threadIdx.x), lane0 = tid & 63, wave = __builtin_amdgcn_readfirstlane(tid >> 6);
  char* slots = smem;
  char* wsm = smem + 4 * HSLOT + wave * 6144;
  bf16_t* Q1 = (bf16_t*)wsm;
  bf16_t* Q2 = (bf16_t*)(wsm + 2048);
  float* F = (float*)(wsm + 4096);
  char* myslot = slots + wave * HSLOT;
  float lb;
  {
    float x0 = P.hgrn_lb[(d * 2 + 0) * 384 + h * 64 + lane0];
    float x1 = P.hgrn_lb[(d * 2 + 1) * 384 + h * 64 + lane0];
    float mx = fmaxf(x0, x1);
    float e0 = expf(x0 - mx), e1 = expf(x1 - mx);
    float w0 = e0 / (e0 + e1), w1 = e1 / (e0 + e1);
    lb = (l == 0) ? 0.f : fmaxf((w0 + w1) - w0, 0.f);
  }
  f32x4 accS[4];
#pragma unroll
  for (int mt = 0; mt < 4; ++mt) accS[mt] = f32x4{0.f, 0.f, 0.f, 0.f};
  for (int rnd = 0; rnd < 36; ++rnd) {
    int L, base;
    if (rnd < 4) { L = CTXL; base = NLAT + b * CTXL; }
    else { L = SEQL; base = b * SEQL; }
    const int rr0 = (rnd < 4) ? rnd : rnd - 4;
    const int lane = opq(lane0), fr = lane & 15, q = lane >> 4, j = lane;
    const int offA = (j >> 5) * 1024 + ((j >> 2) & 3) * 256 + ((j >> 4) & 1) * 8 + (j & 3) * 2;
    {
      const int spos = (rr0 * 4 + wave) * 16;
      float iv[16], gg[16], kh[16];
      float g = 0.f;
      const int t0 = d ? (L - 1 - spos) : spos;
      const int tlo = d ? (t0 - 15) : t0;
      bf16_t qr[16], ir[16], zr[16];
      {
        __amdgpu_buffer_rsrc_t prs = __builtin_amdgcn_make_buffer_rsrc((void*)P.p, 0, 0x7ffffff0, 0x00020000);
        const int lrow = opq(lane) >> 3, lc8 = lane & 7;
        u32x4 pcs[3][2];
#pragma unroll
        for (int g2 = 0; g2 < 3; ++g2) {
          const int colg = (g2 == 0) ? (1664 + h * 64) : ((g2 == 1) ? (2048 + h * 64) : (2432 + d * 384 + h * 64));
          const int so = __builtin_amdgcn_readfirstlane((PTOFF(colg) + (base + tlo) * 128) * 2);
#pragma unroll
          for (int k = 0; k < 2; ++k) pcs[g2][k] = __builtin_amdgcn_raw_buffer_load_b128(prs, (lrow + 8 * k) * 256 + lc8 * 16, so, 0);
        }
#pragma unroll
        for (int g2 = 0; g2 < 3; ++g2)
#pragma unroll
          for (int k = 0; k < 2; ++k) *(u32x4*)(wsm + (g2 * 16 + lrow + 8 * k) * 128 + lc8 * 16) = pcs[g2][k];
        wave_sync();
#pragma unroll
        for (int i = 0; i < 16; ++i) {
          const int r = d ? (15 - i) : i;
          qr[i] = *(const bf16_t*)(wsm + (0 * 16 + r) * 128 + j * 2);
          ir[i] = *(const bf16_t*)(wsm + (1 * 16 + r) * 128 + j * 2);
          zr[i] = *(const bf16_t*)(wsm + (2 * 16 + r) * 128 + j * 2);
        }
        wave_sync();
      }
#pragma unroll
      for (int i = 0; i < 16; ++i) {
        float qv = bf2f(qr[i]);
        iv[i] = bf2f(ir[i]);
        float z = bf2f(zr[i]);
        float sg = sigmf(z);
        float f = lb + (1.f - lb) * sg;
        float k = (1.f - lb) * (1.f - sg);
        g += __logf(f);
        gg[i] = g;
        kh[i] = k;
        float qt = qv * __expf(g);
        Q1[i * 64 + j] = f2bfh(qt);
        Q2[i * 64 + j] = f2bfh(k * __expf(-g));
        *(bf16_t*)(myslot + offA + i * 16) = f2bfh(qt);
      }
      const float gC = g;
      *(float*)(myslot + 8192 + j * 4) = __expf(gC);
#pragma unroll
      for (int qq = 0; qq < 4; ++qq) {
        uint2 o;
        o.x = pk2(kh[4 * qq] * __expf(gC - gg[4 * qq]), kh[4 * qq + 1] * __expf(gC - gg[4 * qq + 1]));
        o.y = pk2(kh[4 * qq + 2] * __expf(gC - gg[4 * qq + 2]), kh[4 * qq + 3] * __expf(gC - gg[4 * qq + 3]));
        *(uint2*)(myslot + 2048 + ((q * 64 + qq * 16 + fr) * 8)) = o;
        o.x = pk2(iv[4 * qq], iv[4 * qq + 1]);
        o.y = pk2(iv[4 * qq + 2], iv[4 * qq + 3]);
        *(uint2*)(myslot + 4096 + ((q * 64 + qq * 16 + fr) * 8)) = o;
      }
      wave_sync();
      f32x4 aA = {0.f, 0.f, 0.f, 0.f};
#pragma unroll
      for (int s = 0; s < 2; ++s) {
        bf16x8 x1 = *(const bf16x8*)(Q1 + fr * 64 + s * 32 + q * 8);
        bf16x8 x2 = *(const bf16x8*)(Q2 + fr * 64 + s * 32 + q * 8);
        aA = MFMA32(x2, x1, aA);
      }
      wave_sync();
      float oi[16];
#pragma unroll
      for (int t = 0; t < 16; ++t) {
        float o = 0.f;
#pragma unroll
        for (int i = 0; i <= t; ++i) o += rlane(aA[i & 3], (i >> 2) * 16 + t) * iv[i];
        oi[t] = o;
      }
#pragma unroll
      for (int qq = 0; qq < 4; ++qq) {
        uint2 o;
        o.x = pk2(oi[4 * qq], oi[4 * qq + 1]);
        o.y = pk2(oi[4 * qq + 2], oi[4 * qq + 3]);
        *(uint2*)(myslot + 6144 + ((q * 64 + qq * 16 + fr) * 8)) = o;
      }
    }
    __syncthreads();
#pragma unroll 1
    for (int sc = 0; sc < 4; ++sc) {
      const char* sl = slots + sc * HSLOT;
      bf16x8 qa0 = *(const bf16x8*)(sl + lane * 16);
      bf16x8 qa1 = *(const bf16x8*)(sl + 1024 + lane * 16);
      U4 kc[4];
      f32x4 pc[4];
#pragma unroll
      for (int mt = 0; mt < 4; ++mt) {
        kc[mt].q = *(const uint2*)(sl + 2048 + (mt * 64 + lane) * 8);
        pc[mt] = *(const f32x4*)(sl + 8192 + (16 * mt + 4 * q) * 4);
      }
      U4 iq;
      iq.q = *(const uint2*)(sl + 4096 + (wave * 64 + lane) * 8);
      uint2 oiq = *(const uint2*)(sl + 6144 + (wave * 64 + lane) * 8);
      bf16x8 B0 = pack8(accS[0], accS[1]);
      bf16x8 B1 = pack8(accS[2], accS[3]);
      f32x4 accO = unpack4(oiq);
      accO = MFMA32(qa0, B0, accO);
      accO = MFMA32(qa1, B1, accO);
#pragma unroll
      for (int mt = 0; mt < 4; ++mt) {
        f32x4 c = accS[mt] * pc[mt];
        accS[mt] = MFMA16(kc[mt].v, iq.v, c);
      }
      const int spos = (rr0 * 4 + sc) * 16;
#pragma unroll
      for (int jj = 0; jj < 4; ++jj) {
        int s = spos + 4 * q + jj;
        int t = d ? (L - 1 - s) : s;
        P.yrec[(size_t)(base + t) * YREC + 768 + d * 384 + h * 64 + 16 * wave + fr] = f2bfh(accO[jj]);
      }
    }
    __syncthreads();
  }
}

__device__ void mix_tile(const Params& P, int l, int tile, float* sm, int part) {
  const int tid = opq(threadIdx.x), lane = tid & 63, wave = __builtin_amdgcn_readfirstlane(tid >> 6);
  int base, segbase, n, tloc0, L, seq0;
  if (tile < 512) { base = tile * 64; segbase = base; n = 64; tloc0 = 0; L = SEQL; seq0 = (tile >> 5) * SEQL; }
  else {
    int ct = tile - 512;
    int b = ct >> 2;
    tloc0 = (ct & 3) * 64;
    segbase = NLAT + b * CTXL;
    base = segbase + tloc0;
    n = CTXL; L = CTXL; seq0 = segbase;
  }
  float* spv = sm;
  float* spT = sm + 80 * 64;
  float* spw = spT + 64 * 68;
  if (part & 1)
  for (int g = 0; g < 4; ++g) {
    int win = 2 << g, left = win >> 1, right = win - 1 - left;
    {
      float vals[20];
#pragma unroll
      for (int k = 0; k < 20; ++k) {
        int e = tid + k * 256;
        int ii = e >> 6, cch = e & 63;
        int tt = tloc0 - 8 + ii;
        vals[k] = (tt >= 0 && tt < n) ? bf2f(P.p[PT(segbase + tt, g * 64 + cch)]) : 0.f;
      }
      f32x4 wv[4];
#pragma unroll
      for (int k = 0; k < 4; ++k) wv[k] = *(const f32x4*)(P.pool_w + (size_t)(l * 4 + g) * 4096 + (tid + k * 256) * 4);
#pragma unroll
      for (int k = 0; k < 20; ++k) spv[tid + k * 256] = vals[k];
#pragma unroll
      for (int k = 0; k < 4; ++k) *(f32x4*)(spw + (tid + k * 256) * 4) = wv[k];
    }
    __syncthreads();
    for (int e = tid; e < 4096; e += 256) {
      int i = e >> 6, cch = e & 63;
      int t = tloc0 + i;
      int lo = max(t - left, 0), hi = min(t + right, n - 1) + 1;
      float s = 0.f;
      for (int tt = lo; tt < hi; ++tt) s += spv[(tt - tloc0 + 8) * 64 + cch];
      spT[cch * 68 + i] = s * frcp((float)(hi - lo)) - spv[(i + 8) * 64 + cch];
    }
    __syncthreads();
    const int col = g * 64 + lane;
    float gatev[16];
#pragma unroll
    for (int r = 0; r < 16; ++r) gatev[r] = bf2f(P.p[PT(base + wave * 16 + r, 3200 + col)]);
    float acc[16];
#pragma unroll
    for (int r = 0; r < 16; ++r) acc[r] = 0.f;
#pragma unroll 4
    for (int cch = 0; cch < 64; ++cch) {
      float w = spw[cch * 64 + lane];
      const f32x4* tp = (const f32x4*)(spT + cch * 68 + wave * 16);
      f32x4 t0 = tp[0], t1 = tp[1], t2 = tp[2], t3 = tp[3];
#pragma unroll
      for (int e = 0; e < 4; ++e) {
        acc[e] += t0[e] * w; acc[4 + e] += t1[e] * w; acc[8 + e] += t2[e] * w; acc[12 + e] += t3[e] * w;
      }
    }
    float psc = P.pool_scale[l * 256 + col];
#pragma unroll
    for (int r = 0; r < 16; ++r) {
      int token = base + wave * 16 + r;
      P.xn[XT(token, col)] = f2bf(acc[r] * psc * siluf(gatev[r]));
    }
    __syncthreads();
  }
  if (part & 2) {
    const int grp = lane >> 4, c4 = (lane & 15) * 4;
#pragma unroll 1
    for (int pass = 0; pass < 3; ++pass) {
      const int hh = pass * 4 + grp;
      const bool isr = hh < 6;
      const int ch = (isr ? hh : hh - 6) * 64 + c4;
      const int uc = 768 + ch;
      const int oya = isr ? ch : 768 + ch, oyb = isr ? 384 + ch : 1152 + ch;
      const int ogate = 3200 + (isr ? 256 : 640) + ch, omix = (isr ? 256 : 640) + ch;
      f32x4 s0 = {0.f, 0.f, 0.f, 0.f}, s1 = s0, s2 = s0, gg = s0, gb = s0;
      if (isr) {
        s0 = *(const f32x4*)(P.rwkv_shift + (l * 3 + 0) * 1408 + uc);
        s1 = *(const f32x4*)(P.rwkv_shift + (l * 3 + 1) * 1408 + uc);
        s2 = *(const f32x4*)(P.rwkv_shift + (l * 3 + 2) * 1408 + uc);
        gg = *(const f32x4*)(P.rwkv_gn_g + l * 384 + ch);
        gb = *(const f32x4*)(P.rwkv_gn_b + l * 384 + ch);
      } else {
        gg = *(const f32x4*)(P.hgrn_norm_g + l * 384 + ch);
      }
#pragma unroll 1
      for (int r0 = 0; r0 < 16; r0 += 4) {
        uint2 ya[4], yb[4], vm[4], vl[4], vh[4], gt[4];
        float bon[4];
#pragma unroll
        for (int u = 0; u < 4; ++u) {
          const int token = base + wave * 16 + r0 + u;
          const int t = token - seq0;
          const bf16_t* yr = P.yrec + (size_t)token * YREC;
          ya[u] = *(const uint2*)(yr + oya);
          yb[u] = *(const uint2*)(yr + oyb);
          gt[u] = *(const uint2*)(P.p + PT(token, ogate));
          vm[u] = make_uint2(0u, 0u); vl[u] = vm[u]; vh[u] = vm[u]; bon[u] = 0.f;
          if (isr) {
            bon[u] = P.bonus[(size_t)token * 12 + hh] + P.bonus[(size_t)token * 12 + 6 + hh];
            const bf16_t* pv = P.p + PT(token, 256 + uc);
            vm[u] = *(const uint2*)pv;
            if (t > 0) vl[u] = *(const uint2*)(pv - 128);
            if (t < L - 1) vh[u] = *(const uint2*)(pv + 128);
          }
        }
#pragma unroll
        for (int u = 0; u < 4; ++u) {
          const int token = base + wave * 16 + r0 + u;
          f32x4 y = unpack4(ya[u]) + unpack4(yb[u]);
          f32x4 gate = unpack4(gt[u]);
          f32x4 o;
          if (isr) {
            float mu = rsum16(y[0] + y[1] + y[2] + y[3]) * (1.f / 64.f);
            f32x4 dl = y - mu;
            float var = rsum16(dl[0] * dl[0] + dl[1] * dl[1] + dl[2] * dl[2] + dl[3] * dl[3]) * (1.f / 64.f);
            float rs = __builtin_amdgcn_rsqf(var + GN_EPS_F);
            f32x4 v = s1 * unpack4(vm[u]) + s0 * unpack4(vl[u]) + s2 * unpack4(vh[u]);
#pragma unroll
            for (int e = 0; e < 4; ++e) o[e] = (dl[e] * rs * gg[e] + gb[e] + bon[u] * v[e]) * siluf(gate[e]);
          } else {
            float ms = rsum16(y[0] * y[0] + y[1] * y[1] + y[2] * y[2] + y[3] * y[3]) * (1.f / 64.f);
            float rs = __builtin_amdgcn_rsqf(ms + RMS_EPS_F);
#pragma unroll
            for (int e = 0; e < 4; ++e) o[e] = y[e] * rs * gg[e] * siluf(gate[e]);
          }
          uint2 ov;
          ov.x = pk2(o[0], o[1]); ov.y = pk2(o[2], o[3]);
          *(uint2*)(P.xn + XT(token, omix)) = ov;
        }
      }
    }
  }
}

#define XB_TMO      128
#define XB_XCNT(j)  (256  + 64 * (j))
#define XB_XSUB(j)  (1280 + 64 * (j))
#define XB_XGEN(j)  (2304 + 64 * (j))
#define XB_TOP      3328
#define XB_TOPGEN   3392
#define XCD_BAR_WORDS 3456
#define XB_SPIN_CAP (1u << 18)
__device__ __forceinline__ unsigned xb_ld(unsigned* p) { return __hip_atomic_load(p, __ATOMIC_RELAXED, __HIP_MEMORY_SCOPE_AGENT); }
__device__ __forceinline__ unsigned xb_add(unsigned* p, unsigned v) { return __hip_atomic_fetch_add(p, v, __ATOMIC_RELAXED, __HIP_MEMORY_SCOPE_AGENT); }
__device__ __forceinline__ unsigned xb_xcc_id() { return (unsigned)__builtin_amdgcn_s_getreg((3 << 11) | 20) & 0xFu; }
#define XB_SPIN(cond, bar) do { unsigned _sp = 0; while (cond) { __builtin_amdgcn_s_sleep(1); \
    if ((++_sp & 255u) == 0u) { if (xb_ld(&(bar)[XB_TMO])) break; if (_sp > XB_SPIN_CAP) { atomicAdd(&(bar)[XB_TMO], 1u); break; } } } } while (0)
__device__ __forceinline__ void xcd_barrier(unsigned* bar, unsigned x, unsigned nloc, unsigned nx) {
  asm volatile("s_waitcnt vmcnt(0)" ::: "memory");
  __syncthreads();
  if (threadIdx.x == 0) {
    __builtin_amdgcn_s_waitcnt(0);
    const unsigned old = xb_add(&bar[XB_XSUB(x)], 1u);
    const unsigned gen = old / nloc;
    if (old + 1u == (gen + 1u) * nloc) {
      __builtin_amdgcn_fence(__ATOMIC_RELEASE, "agent");
      asm volatile("s_waitcnt vmcnt(0)" ::: "memory");
      const unsigned og = xb_add(&bar[XB_TOP], 1u);
      const unsigned tg = og / nx;
      if (og + 1u == (tg + 1u) * nx) xb_add(&bar[XB_TOPGEN], 1u);
      else XB_SPIN(xb_ld(&bar[XB_TOPGEN]) == tg, bar);
      __builtin_amdgcn_fence(__ATOMIC_ACQUIRE, "agent");
      xb_add(&bar[XB_XGEN(x)], 1u);
      asm volatile("s_waitcnt vmcnt(0)" ::: "memory");
    } else {
      XB_SPIN(xb_ld(&bar[XB_XGEN(x)]) == gen, bar);
      __builtin_amdgcn_fence(__ATOMIC_ACQUIRE, "agent");
      asm volatile("s_waitcnt vmcnt(0)" ::: "memory");
    }
  }
  __syncthreads();
}

__device__ void p0_unit(const Params& P, int u, float* smf) {
  if (u < 2 * 1056) {
    int l = u / 1056, r = u % 1056;
    transpose_tile(P.w_in + (size_t)l * 1024 * DIN, DIN, P.WtIn + (size_t)l * DIN * 1024, r / 66, r % 66, smf);
  } else if (u < 2 * 1056 + 2 * 256) {
    int v = u - 2 * 1056;
    int l = v / 256, r = v % 256;
    transpose_tile(P.w_out + (size_t)l * 1024 * 1024, 1024, P.WtOut + (size_t)l * 1024 * 1024, r / 16, r % 16, smf);
  } else if (u < 2 * 1056 + 512 + 384) {
    int v = u - 2 * 1056 - 512;
    mod_unit(P, v / 192, v % 192, smf);
  } else {
    int v = u - 2 * 1056 - 512 - 384;
    int which = v / 24, r = v % 24;
    const float* src = (which ? P.rwkv_a_up : P.rwkv_w_up) + (size_t)(r / 6) * 64 * 384 + (r % 6) * 64;
    bf16_t* dst = P.loraT + (size_t)v * 4096;
    for (int e = opq(threadIdx.x); e < 4096; e += 256) {
      int jj = e >> 6, m = e & 63;
      dst[e] = f2bf(src[m * 384 + jj]);
    }
    __syncthreads();
  }
}

__global__ void __launch_bounds__(256, 2) fwd_megakernel(Params P) {
  cg::grid_group grid = cg::this_grid();
  __shared__ __attribute__((aligned(16))) char smem[SMEM_BYTES];
  float* smf = (float*)smem;
  const int bid = blockIdx.x, nblk = gridDim.x;
  const unsigned xcc = xb_xcc_id();
  if (threadIdx.x == 0) {
    *(unsigned*)smem = xb_add(&P.bar[XB_XCNT(xcc)], 1u);
    if (xcc != (unsigned)(bid & 7)) (void)xb_add(&P.bar[64], 1u);
  }
  __syncthreads();
  const int xslot = __builtin_amdgcn_readfirstlane(*(const unsigned*)smem);
  __syncthreads();

  const bool defer_p0 = nblk > 384;
  for (int rep = 0; rep < REP_P0; ++rep) {
    if (defer_p0) {
      for (int e = bid; e < 1272; e += nblk) {
        int u;
        if (e < 192) u = 2624 + e;
        else if (e < 216) { int le = e - 192; u = 3008 + (le / 12) * 24 + (le % 12); }
        else u = e - 216;
        p0_unit(P, u, smf);
      }
    } else {
      for (int u = bid; u < 3056; u += nblk) p0_unit(P, u, smf);
    }
  }
  if (gridDim.x == 0x7fffffffu) grid.sync();
  unsigned nloc = 0u, nxc = 0u, nlow = 0u;
  {
    __syncthreads();
    if (threadIdx.x == 0) {
      unsigned sp = 0u, a = 0u, bq = 0u, cq = 0u;
      for (;;) {
        unsigned sum = 0u;
        a = 0u; bq = 0u; cq = 0u;
#pragma unroll
        for (unsigned jx = 0; jx < 16; ++jx) {
          const unsigned c = xb_ld(&P.bar[XB_XCNT(jx)]);
          sum += c;
          bq += (c > 0u) ? 1u : 0u;
          cq += (jx < 8u && c > 0u) ? 1u : 0u;
          a = (jx == xcc) ? c : a;
        }
        if (sum == gridDim.x) break;
        __builtin_amdgcn_s_sleep(1);
        if ((++sp & 255u) == 0u) { if (xb_ld(&P.bar[XB_TMO])) break; if (sp > XB_SPIN_CAP) { atomicAdd(&P.bar[XB_TMO], 1u); break; } }
      }
      ((unsigned*)smem)[0] = a; ((unsigned*)smem)[1] = bq; ((unsigned*)smem)[2] = cq;
    }
    __syncthreads();
    nloc = ((const unsigned*)smem)[0]; nxc = ((const unsigned*)smem)[1]; nlow = ((const unsigned*)smem)[2];
    __syncthreads();
    nlow = __builtin_amdgcn_readfirstlane(nlow);
    nloc = __builtin_amdgcn_readfirstlane(nloc > 0u ? nloc : 1u);
    nxc = __builtin_amdgcn_readfirstlane(nxc > 0u ? nxc : 1u);
  }
  xcd_barrier(P.bar, xcc, nloc, nxc);
  const unsigned placemis = __builtin_amdgcn_readfirstlane(xb_ld(&P.bar[64]));
  const int gslot = (placemis == 0u && nblk == 512 && nloc == 64u) ? (bid >> 3) : xslot;

  for (int l = 0; l < 2; ++l) {
    ln_phase(P, l);
    xcd_barrier(P.bar, xcc, nloc, nxc);
    for (int rep = 0; rep < REP_G1; ++rep) {
      if (nxc == 8u && nlow == 8u) {
        const int xcd = (int)xcc, slot = gslot, nslot = (int)nloc;
        for (int i = slot; i < 36 * 33; i += nslot) {
          int mg = i / 132, r = i % 132;
          int nt = r >> 2, mt = xcd * 36 + mg * 4 + (r & 3);
          gemm_tile<0>(P, l, P.xn, P.WtIn + (size_t)l * DIN * 1024, mt * 128, nt * 128, smem);
        }
      } else {
        for (int t = bid; t < 288 * 33; t += nblk) {
          int mt = t / 33, nt = t % 33;
          gemm_tile<0>(P, l, P.xn, P.WtIn + (size_t)l * DIN * 1024, mt * 128, nt * 128, smem);
        }
      }
    }
    xcd_barrier(P.bar, xcc, nloc, nxc);
    const bool grid512 = (nblk == 512);
    int sidx = -1, nside = 0;
    if (grid512) { nside = 128; sidx = (bid >= 192 && bid < 256) ? (bid - 192) : ((bid >= 448) ? (64 + bid - 448) : -1); }
    else if (nblk > 384) { nside = nblk - 384; sidx = (bid >= 384) ? (bid - 384) : -1; }
    for (int rep = 0; rep < REP_SCAN; ++rep)
    for (int u0 = bid; u0 < (grid512 ? 512 : 384); u0 += nblk) {
      int u = u0;
      if (grid512) {
        if (u0 < 192) u = u0;
        else if (u0 >= 256 && u0 < 448) u = 192 + (u0 - 256);
        else continue;
      }
      int type = u / 192, rem = u % 192;
      int d = rem / 96, b = (rem % 96) / 6, h = rem % 6;
      if (type == 0) rwkv_unit2(P, l, b, h, d, smem, rem);
      else hgrn_unit2(P, l, b, h, d, smem);
    }
    const bool pool_in_scan = nblk > 384;
    if (pool_in_scan && sidx >= 0) {
      const int ntile_p = (l == 0) ? 576 : 512;
      for (int t = sidx; t < ntile_p; t += nside) mix_tile(P, l, t, smf, 1);
      if (l == 0) {
        for (int f = sidx; f < 1784; f += nside) {
          int u;
          if (f < 1056) u = 1056 + f;
          else if (f < 1568) u = 2112 + (f - 1056);
          else if (f < 1760) u = 2624 + 192 + (f - 1568);
          else { int lf = f - 1760; u = 3008 + (lf / 12) * 24 + 12 + (lf % 12); }
          p0_unit(P, u, smf);
        }
      }
    }
    xcd_barrier(P.bar, xcc, nloc, nxc);
    {
      int ntile = (l == 0) ? 576 : 512;
      for (int rep = 0; rep < REP_MIX; ++rep)
      for (int t = bid; t < ntile; t += nblk) mix_tile(P, l, t, smf, (nblk > 384) ? 2 : 3);
    }
    xcd_barrier(P.bar, xcc, nloc, nxc);
    {
      int nmt = (l == 0) ? 288 : 256;
      for (int rep = 0; rep < ((l == 0) ? REP_G2 : 1); ++rep) {
        if (nxc == 8u && nlow == 8u) {
          const int xcd = (int)xcc, slot = gslot, nslot = (int)nloc, mpx = nmt >> 3;
          for (int i = slot; i < mpx * 8; i += nslot) {
            int mt = xcd * mpx + (i >> 3), nt = i & 7;
            gemm_tile<1>(P, l, P.xn, P.WtOut + (size_t)l * 1024 * 1024, mt * 128, nt * 128, smem);
          }
        } else {
          for (int t = bid; t < nmt * 8; t += nblk) {
            int mt = t / 8, nt = t % 8;
            gemm_tile<1>(P, l, P.xn, P.WtOut + (size_t)l * 1024 * 1024, mt * 128, nt * 128, smem);
          }
        }
      }
    }
    xcd_barrier(P.bar, xcc, nloc, nxc);
  }
  final_ln_phase(P);
}

extern "C" void kernel_launch(void* const* d_in, const int* in_sizes, int n_in, void* d_out, int out_size, void* d_ws,
                              size_t ws_size, hipStream_t stream) {
  static int grid_blocks = 0;
  if (!grid_blocks) {
    int dev = 0, cus = 0, per_cu = 0;
    hipGetDevice(&dev);
    hipDeviceGetAttribute(&cus, hipDeviceAttributeMultiprocessorCount, dev);
    hipOccupancyMaxActiveBlocksPerMultiprocessor(&per_cu, fwd_megakernel, 256, 0);
    if (per_cu > 2) per_cu = 2;
    grid_blocks = cus * per_cu;
  }
  Params p{};
  const float* const* in = (const float* const*)d_in;
  p.x = in[0]; p.c = in[1]; p.ctx = in[2]; p.c_ctx = in[3]; p.mod_w = in[4]; p.mod_b = in[5]; p.w_in = in[6];
  p.rwkv_shift = in[7]; p.pool_w = in[8]; p.pool_scale = in[9]; p.rwkv_w0 = in[10]; p.rwkv_w_up = in[11];
  p.rwkv_a0 = in[12]; p.rwkv_a_up = in[13]; p.rwkv_k_k = in[14]; p.rwkv_k_a = in[15]; p.rwkv_r_k = in[16];
  p.rwkv_gn_g = in[17]; p.rwkv_gn_b = in[18]; p.hgrn_lb = in[19]; p.hgrn_norm_g = in[20]; p.w_out = in[21];
  p.ln_g = in[22]; p.ln_b = in[23];
  p.out = (float*)d_out;
  char* ws = (char*)d_ws;
  size_t off = 0;
  auto take = [&](size_t bytes) { char* r = ws + off; off += (bytes + 255) & ~(size_t)255; return r; };
  p.WtIn = (bf16_t*)take((size_t)2 * DIN * 1024 * 2);
  p.WtOut = (bf16_t*)take((size_t)2 * 1024 * 1024 * 2);
  p.mod = (float*)take((size_t)2 * 17 * 3072 * 4);
  p.xn = (bf16_t*)take((size_t)NTOK * 1024 * 2);
  p.p = (bf16_t*)take((size_t)NTOK * DIN * 2);
  p.yrec = (bf16_t*)take((size_t)NTOK * YREC * 2);
  p.bonus = (float*)take((size_t)NTOK * 12 * 4);
  p.loraT = (bf16_t*)take((size_t)48 * 4096 * 2);
  p.ring = take((size_t)192 * 4 * RSLOT);
  p.bar = (unsigned*)take((size_t)XCD_BAR_WORDS * 4);
  p.hprectx = (float*)p.p;
  if (off > ws_size) { fprintf(stderr, "workspace too small: need %zu have %zu\n", off, ws_size); return; }
  hipMemsetAsync(p.bar, 0, (size_t)XCD_BAR_WORDS * 4, stream);
  void* args[] = {&p};
  hipError_t e = hipLaunchCooperativeKernel((void*)fwd_megakernel, dim3(grid_blocks), dim3(256), args, 0, stream);
  if (e != hipSuccess) fprintf(stderr, "cooperative launch failed: %s (grid %d)\n", hipGetErrorString(e), grid_blocks);
}
```

```cpp
#include <hip/hip_runtime.h>
#include <hip/hip_bf16.h>
#include <hip/hip_cooperative_groups.h>
#include <cstdio>
namespace cg = cooperative_groups;

typedef unsigned short bf16_t;
using bf16x8 = __attribute__((ext_vector_type(8))) short;
using f32x4 = __attribute__((ext_vector_type(4))) float;
using u32x4 = __attribute__((ext_vector_type(4))) unsigned;

#define DM 1024
#define NB 16
#define SEQL 2048
#define CTXL 256
#define NLAT 32768
#define NCTX 4096
#define NTOK 36864
#define DIN 4224
#define ALPHA_F 1.4142135623730951f
#define LN_EPS_F 1e-5f
#define GN_EPS_F 64e-5f
#define RMS_EPS_F 1e-6f
#define YREC 1536
#define PTOFF(col) ((((col) >> 7) * NTOK) * 128 + ((col) & 127))
#define PT(tok, col) ((size_t)PTOFF(col) + (size_t)(tok) * 128)
#define XT(row, k) ((size_t)(((k) >> 6) * NTOK + (row)) * 64 + ((k) & 63))
#define SMEM_BYTES 65536
#ifndef REP_P0
#define REP_P0 1
#endif
#ifndef REP_LN
#define REP_LN 1
#endif
#ifndef REP_G1
#define REP_G1 1
#endif
#ifndef REP_SCAN
#define REP_SCAN 1
#endif
#ifndef REP_MIX
#define REP_MIX 1
#endif
#ifndef REP_G2
#define REP_G2 1
#endif

struct Params {
  const float *x, *c, *ctx, *c_ctx, *mod_w, *mod_b, *w_in, *rwkv_shift, *pool_w, *pool_scale,
      *rwkv_w0, *rwkv_w_up, *rwkv_a0, *rwkv_a_up, *rwkv_k_k, *rwkv_k_a, *rwkv_r_k, *rwkv_gn_g, *rwkv_gn_b,
      *hgrn_lb, *hgrn_norm_g, *w_out, *ln_g, *ln_b;
  float* out;
  bf16_t *WtIn, *WtOut, *xn, *p, *yrec;
  float *mod, *bonus, *hprectx;
  bf16_t* loraT;
  char* ring;
  unsigned* bar;
};

__device__ __forceinline__ float bf2f(bf16_t v) { return __uint_as_float(((unsigned)v) << 16); }
__device__ __forceinline__ bf16_t f2bf(float f) {
  unsigned u = __float_as_uint(f);
  u += 0x7fffu + ((u >> 16) & 1u);
  return (bf16_t)(u >> 16);
}
#define DPPF(v, ctrl) __builtin_bit_cast(float, __builtin_amdgcn_update_dpp(0, __builtin_bit_cast(int, (v)), (ctrl), 0xf, 0xf, true))
__device__ __forceinline__ float rsum16(float v) {
  v += DPPF(v, 0xB1);
  v += DPPF(v, 0x4E);
  v += DPPF(v, 0x141);
  v += DPPF(v, 0x140);
  return v;
}
__device__ __forceinline__ float wsum(float v) {
  v = rsum16(v);
  int iv = __builtin_bit_cast(int, v);
  float a = __builtin_bit_cast(float, __builtin_amdgcn_readlane(iv, 0));
  float b = __builtin_bit_cast(float, __builtin_amdgcn_readlane(iv, 16));
  float c = __builtin_bit_cast(float, __builtin_amdgcn_readlane(iv, 32));
  float d = __builtin_bit_cast(float, __builtin_amdgcn_readlane(iv, 48));
  return (a + b) + (c + d);
}
__device__ __forceinline__ int opq(int v) { asm volatile("" : "+v"(v)); return v; }
__device__ __forceinline__ float frcp(float x) { return __builtin_amdgcn_rcpf(x); }
__device__ __forceinline__ float siluf(float x) { return x * frcp(1.f + __expf(-x)); }
__device__ __forceinline__ float sigmf(float x) { return frcp(1.f + __expf(-x)); }
__device__ __forceinline__ float ftanh(float x) { return 1.f - 2.f * frcp(1.f + __expf(2.f * x)); }

__device__ void transpose_tile(const float* __restrict__ W, int N, bf16_t* __restrict__ Wt, int kt, int nt, float* sm) {
  int tid = opq(threadIdx.x);
  {
    float vals[16];
#pragma unroll
    for (int k = 0; k < 16; ++k) {
      int e = tid + k * 256;
      int kk = e >> 6, nn = e & 63;
      vals[k] = W[(size_t)(kt * 64 + kk) * N + nt * 64 + nn];
    }
#pragma unroll
    for (int k = 0; k < 16; ++k) {
      int e = tid + k * 256;
      sm[(e >> 6) * 65 + (e & 63)] = vals[k];
    }
  }
  __syncthreads();
  for (int e = tid; e < 4096; e += 256) {
    int nn = e >> 6, kk = e & 63;
    Wt[((size_t)kt * N + nt * 64 + nn) * 64 + kk] = f2bf(sm[kk * 65 + nn]);
  }
  __syncthreads();
}

__device__ void mod_unit(const Params& P, int l, int cb, float* sm) {
  int tid = opq(threadIdx.x), j = tid & 15, kp = tid >> 4;
  float acc[17];
#pragma unroll
  for (int r = 0; r < 17; ++r) acc[r] = 0.f;
  const float* W = P.mod_w + (size_t)l * 1024 * 3072 + cb * 16 + j;
  for (int pass = 0; pass < 2; ++pass) {
    for (int e = tid; e < 17 * 512; e += 256) {
      int r = e >> 9, k = (e & 511) + pass * 512;
      float v = (r < 16) ? P.c[r * 1024 + k] : P.c_ctx[k];
      sm[e] = siluf(v);
    }
    __syncthreads();
    {
      const int k0 = kp * 32;
      float wv[32];
#pragma unroll
      for (int u = 0; u < 32; ++u) wv[u] = W[(size_t)(pass * 512 + k0 + u) * 3072];
#pragma unroll
      for (int u = 0; u < 32; ++u) {
#pragma unroll
        for (int r = 0; r < 17; ++r) acc[r] += sm[r * 512 + k0 + u] * wv[u];
      }
    }
    __syncthreads();
  }
#pragma unroll
  for (int r = 0; r < 17; ++r) sm[(kp * 17 + r) * 16 + j] = acc[r];
  __syncthreads();
  for (int e = tid; e < 17 * 16; e += 256) {
    int r = e >> 4, jj = e & 15;
    float s0 = 0.f;
#pragma unroll
    for (int k = 0; k < 16; ++k) s0 += sm[(k * 17 + r) * 16 + jj];
    int col = cb * 16 + jj;
    P.mod[((size_t)l * 17 + r) * 3072 + col] = s0 + P.mod_b[l * 3072 + col];
  }
  __syncthreads();
}

__device__ __forceinline__ void ln16(float (&v)[16]) {
  float s = 0.f;
#pragma unroll
  for (int i = 0; i < 16; ++i) s += v[i];
  float mu = wsum(s) * (1.f / 1024.f);
  float q = 0.f;
#pragma unroll
  for (int i = 0; i < 16; ++i) { v[i] -= mu; q += v[i] * v[i]; }
  float rs = rsqrtf(wsum(q) * (1.f / 1024.f) + LN_EPS_F);
#pragma unroll
  for (int i = 0; i < 16; ++i) v[i] *= rs;
}

__device__ void ln_phase(const Params& P, int l) {
  const int tidq = opq(threadIdx.x);
  int lane = tidq & 63;
  int gw = (blockIdx.x * 256 + tidq) >> 6, nw = (gridDim.x * 256) >> 6;
#pragma unroll 2
  for (int row = gw; row < NTOK; row += nw) {
    const float* src;
    int r;
    if (row < NLAT) { src = (l == 0 ? P.x : P.out) + (size_t)row * 1024; r = row >> 11; }
    else { src = (l == 0 ? P.ctx : P.hprectx) + (size_t)(row - NLAT) * 1024; r = 16; }
    float v[16];
#pragma unroll
    for (int i = 0; i < 4; ++i) {
      float4 t = *(const float4*)(src + i * 256 + lane * 4);
      v[i * 4] = t.x; v[i * 4 + 1] = t.y; v[i * 4 + 2] = t.z; v[i * 4 + 3] = t.w;
    }
    if (l > 0) {
      ln16(v);
#pragma unroll
      for (int i = 0; i < 4; ++i) {
        float4 g = *(const float4*)(P.ln_g + (l - 1) * 1024 + i * 256 + lane * 4);
        float4 bb = *(const float4*)(P.ln_b + (l - 1) * 1024 + i * 256 + lane * 4);
        v[i * 4] = v[i * 4] * g.x + bb.x; v[i * 4 + 1] = v[i * 4 + 1] * g.y + bb.y;
        v[i * 4 + 2] = v[i * 4 + 2] * g.z + bb.z; v[i * 4 + 3] = v[i * 4 + 3] * g.w + bb.w;
      }
      if (row < NLAT) {
#pragma unroll
        for (int i = 0; i < 4; ++i)
          *(float4*)(P.out + (size_t)row * 1024 + i * 256 + lane * 4) = make_float4(v[i * 4], v[i * 4 + 1], v[i * 4 + 2], v[i * 4 + 3]);
      }
    }
    ln16(v);
    const float* md = P.mod + ((size_t)l * 17 + r) * 3072;
#pragma unroll
    for (int i = 0; i < 4; ++i) {
      float4 sh = *(const float4*)(md + i * 256 + lane * 4);
      float4 sc = *(const float4*)(md + 1024 + i * 256 + lane * 4);
      ushort4 o;
      o.x = f2bf(v[i * 4] * (1.f + sc.x) + sh.x);
      o.y = f2bf(v[i * 4 + 1] * (1.f + sc.y) + sh.y);
      o.z = f2bf(v[i * 4 + 2] * (1.f + sc.z) + sh.z);
      o.w = f2bf(v[i * 4 + 3] * (1.f + sc.w) + sh.w);
      *(ushort4*)(P.xn + XT(row, i * 256 + lane * 4)) = o;
    }
  }
}

__device__ void final_ln_phase(const Params& P) {
  const int tidq = opq(threadIdx.x);
  int lane = tidq & 63;
  int gw = (blockIdx.x * 256 + tidq) >> 6, nw = (gridDim.x * 256) >> 6;
  for (int row = gw; row < NLAT; row += nw) {
    float* src = P.out + (size_t)row * 1024;
    float v[16];
#pragma unroll
    for (int i = 0; i < 4; ++i) {
      float4 t = *(const float4*)(src + i * 256 + lane * 4);
      v[i * 4] = t.x; v[i * 4 + 1] = t.y; v[i * 4 + 2] = t.z; v[i * 4 + 3] = t.w;
    }
    ln16(v);
#pragma unroll
    for (int i = 0; i < 4; ++i) {
      float4 g = *(const float4*)(P.ln_g + 1024 + i * 256 + lane * 4);
      float4 bb = *(const float4*)(P.ln_b + 1024 + i * 256 + lane * 4);
      *(float4*)(src + i * 256 + lane * 4) = make_float4(v[i * 4] * g.x + bb.x, v[i * 4 + 1] * g.y + bb.y,
                                                          v[i * 4 + 2] * g.z + bb.z, v[i * 4 + 3] * g.w + bb.w);
    }
  }
}

typedef __bf16 bf2e_t __attribute__((ext_vector_type(2)));
typedef float fl2e_t __attribute__((ext_vector_type(2)));
__device__ __forceinline__ unsigned pk2(float a, float b) {
  fl2e_t f = {a, b};
  bf2e_t h = __builtin_convertvector(f, bf2e_t);
  return __builtin_bit_cast(unsigned, h);
}
template <int MODE>
__device__ void gemm_tile(const Params& P, int l, const bf16_t* __restrict__ A, const bf16_t* __restrict__ Bt,
                          int row0, int col0, char* smem) {
  const int tid = opq(threadIdx.x), lane = tid & 63, wave = tid >> 6, wr = wave >> 1, wc = wave & 1, fr = lane & 15, fq = lane >> 4;
  f32x4 acc[4][4];
#pragma unroll
  for (int m = 0; m < 4; ++m)
#pragma unroll
    for (int n = 0; n < 4; ++n) acc[m][n] = f32x4{0.f, 0.f, 0.f, 0.f};
  u32x4 ra0[4], rb0[4], ra1[4], rb1[4];
  const int crow = tid >> 3, c16 = tid & 7;
  const int NBR = (MODE == 0) ? DIN : 1024;
  const bf16_t* Ag = A + (size_t)(row0 + crow) * 64 + c16 * 8;
  const bf16_t* Bg = Bt + (size_t)(col0 + crow) * 64 + c16 * 8;
#define GLOAD(RA, RB, kt)                                                                           \
  _Pragma("unroll") for (int i = 0; i < 4; ++i) {                                                   \
    asm volatile("global_load_dwordx4 %0, %1, off" : "=v"(RA[i]) : "v"(Ag + (size_t)i * 32 * 64 + (size_t)(kt) * NTOK * 64)); \
    asm volatile("global_load_dwordx4 %0, %1, off" : "=v"(RB[i]) : "v"(Bg + (size_t)i * 32 * 64 + (size_t)(kt) * NBR * 64)); \
  }
#define LSTORE(RA, RB, s)                                                                  \
  _Pragma("unroll") for (int i = 0; i < 4; ++i) {                                          \
    *(u32x4*)(smem + (s) * 32768 + (crow + i * 32) * 128 + ((c16 ^ (((crow + i * 32) >> 1) & 7)) << 4)) = RA[i];          \
    *(u32x4*)(smem + (s) * 32768 + 16384 + (crow + i * 32) * 128 + ((c16 ^ (((crow + i * 32) >> 1) & 7)) << 4)) = RB[i];  \
  }
#define COMPUTE(s)                                                                                                   \
  {                                                                                                                  \
    const char* sA = smem + (s) * 32768;                                                                             \
    const char* sB = sA + 16384;                                                                                     \
    bf16x8 af0[4], bf0[4], af1[4], bf1[4];                                                                           \
    _Pragma("unroll") for (int m = 0; m < 4; ++m)                                                                    \
      af0[m] = *(const bf16x8*)(sA + (wr * 64 + m * 16 + fr) * 128 + (((0 + fq) ^ ((fr >> 1) & 7)) << 4));           \
    _Pragma("unroll") for (int n = 0; n < 4; ++n)                                                                    \
      bf0[n] = *(const bf16x8*)(sB + (wc * 64 + n * 16 + fr) * 128 + (((0 + fq) ^ ((fr >> 1) & 7)) << 4));           \
    _Pragma("unroll") for (int m = 0; m < 4; ++m)                                                                    \
      af1[m] = *(const bf16x8*)(sA + (wr * 64 + m * 16 + fr) * 128 + (((4 + fq) ^ ((fr >> 1) & 7)) << 4));           \
    _Pragma("unroll") for (int n = 0; n < 4; ++n)                                                                    \
      bf1[n] = *(const bf16x8*)(sB + (wc * 64 + n * 16 + fr) * 128 + (((4 + fq) ^ ((fr >> 1) & 7)) << 4));           \
    __builtin_amdgcn_sched_barrier(0);                                                                               \
    __builtin_amdgcn_s_setprio(1);                                                                                   \
    _Pragma("unroll") for (int m = 0; m < 4; ++m)                                                                    \
      _Pragma("unroll") for (int n = 0; n < 4; ++n)                                                                  \
        acc[m][n] = __builtin_amdgcn_mfma_f32_16x16x32_bf16(bf0[n], af0[m], acc[m][n], 0, 0, 0);                     \
    _Pragma("unroll") for (int m = 0; m < 4; ++m)                                                                    \
      _Pragma("unroll") for (int n = 0; n < 4; ++n)                                                                  \
        acc[m][n] = __builtin_amdgcn_mfma_f32_16x16x32_bf16(bf1[n], af1[m], acc[m][n], 0, 0, 0);                     \
    __builtin_amdgcn_s_setprio(0);                                                                                   \
  }
  GLOAD(ra0, rb0, 0);
  asm volatile("s_waitcnt vmcnt(0)" ::: "memory");
  LSTORE(ra0, rb0, 0);
  GLOAD(ra0, rb0, 1);
  __syncthreads();
  for (int kt = 0; kt < 16; kt += 2) {
    if (kt + 2 < 16) { GLOAD(ra1, rb1, kt + 2); }
    __builtin_amdgcn_sched_barrier(0);
    COMPUTE(0);
    __builtin_amdgcn_sched_barrier(0);
    if (kt + 2 < 16) asm volatile("s_waitcnt vmcnt(8)" ::: "memory");
    else asm volatile("s_waitcnt vmcnt(0)" ::: "memory");
    LSTORE(ra0, rb0, 1);
    __syncthreads();
    if (kt + 3 < 16) { GLOAD(ra0, rb0, kt + 3); }
    __builtin_amdgcn_sched_barrier(0);
    COMPUTE(1);
    __builtin_amdgcn_sched_barrier(0);
    if (kt + 2 < 16) {
      if (kt + 3 < 16) asm volatile("s_waitcnt vmcnt(8)" ::: "memory");
      else asm volatile("s_waitcnt vmcnt(0)" ::: "memory");
      LSTORE(ra1, rb1, 0);
    }
    __syncthreads();
  }
#undef COMPUTE
#undef GLOAD
#undef LSTORE
#pragma unroll
  for (int m = 0; m < 4; ++m) {
    int row = row0 + wr * 64 + m * 16 + fr;
#pragma unroll
    for (int n = 0; n < 4; ++n) {
      int col = col0 + wc * 64 + n * 16 + fq * 4;
      if (MODE == 0) {
        uint2 o;
        o.x = pk2(acc[m][n][0], acc[m][n][1]); o.y = pk2(acc[m][n][2], acc[m][n][3]);
        *(uint2*)(smem + (row - row0) * 272 + (col - col0) * 2) = o;
      } else {
        const float* hsrc;
        float* dst;
        int r;
        if (row < NLAT) {
          hsrc = (l == 0 ? P.x : P.out) + (size_t)row * 1024 + col;
          dst = P.out + (size_t)row * 1024 + col;
          r = row >> 11;
        } else {
          hsrc = P.ctx + (size_t)(row - NLAT) * 1024 + col;
          dst = P.hprectx + (size_t)(row - NLAT) * 1024 + col;
          r = 16;
        }
        float4 hv = *(const float4*)hsrc;
        float4 gt = *(const float4*)(P.mod + ((size_t)l * 17 + r) * 3072 + 2048 + col);
        float4 o;
        o.x = ALPHA_F * hv.x + gt.x * acc[m][n][0];
        o.y = ALPHA_F * hv.y + gt.y * acc[m][n][1];
        o.z = ALPHA_F * hv.z + gt.z * acc[m][n][2];
        o.w = ALPHA_F * hv.w + gt.w * acc[m][n][3];
        *(float4*)dst = o;
      }
    }
  }
  if (MODE == 0) {
    __syncthreads();
#pragma unroll
    for (int i = 0; i < 8; ++i) {
      const int c = tid + 256 * i, rr = c >> 4, cc = c & 15;
      u32x4 v = *(const u32x4*)(smem + rr * 272 + cc * 16);
      *(u32x4*)(P.p + PT(row0 + rr, col0) + cc * 8) = v;
    }
    __syncthreads();
  }
}

typedef __bf16 bf2_t __attribute__((ext_vector_type(2)));
typedef float fl2_t __attribute__((ext_vector_type(2)));
using bf16x4 = __attribute__((ext_vector_type(4))) short;
__device__ __forceinline__ bf16_t f2bfh(float a) { return (bf16_t)(pk2(a, 0.f) & 0xffffu); }
__device__ __forceinline__ float rlane(float x, int l) {
  return __builtin_bit_cast(float, __builtin_amdgcn_readlane(__builtin_bit_cast(int, x), l));
}
__device__ __forceinline__ void wave_sync() {
  asm volatile("s_waitcnt lgkmcnt(0)" ::: "memory");
  __builtin_amdgcn_wave_barrier();
}
union U8 { bf16x8 v; unsigned u[4]; uint4 q; };
union U4 { bf16x4 v; unsigned u[2]; uint2 q; };
__device__ __forceinline__ bf16x8 pack8(f32x4 a, f32x4 b) {
  U8 r;
  r.u[0] = pk2(a[0], a[1]); r.u[1] = pk2(a[2], a[3]); r.u[2] = pk2(b[0], b[1]); r.u[3] = pk2(b[2], b[3]);
  return r.v;
}
__device__ __forceinline__ f32x4 unpack4(uint2 w) {
  f32x4 r;
  r[0] = __uint_as_float(w.x << 16); r[1] = __uint_as_float(w.x & 0xffff0000u);
  r[2] = __uint_as_float(w.y << 16); r[3] = __uint_as_float(w.y & 0xffff0000u);
  return r;
}
#define RSLOT 14592
using u32x2 = __attribute__((ext_vector_type(2))) unsigned;
#define GLD(T, p) (*(const __attribute__((address_space(1))) T*)(p))
#define GST(T, p, v) (*(__attribute__((address_space(1))) T*)(p) = (v))
#define MFMA32(a, b, c) __builtin_amdgcn_mfma_f32_16x16x32_bf16(a, b, c, 0, 0, 0)
#define MFMA16(a, b, c) __builtin_amdgcn_mfma_f32_16x16x16bf16_1k(a, b, c, 0, 0, 0)

__device__ void rwkv_unit2(const Params& P, int l, int b, int h, int d, char* smem, int unit) {
  const int tid = opq(threadIdx.x), lane0 = tid & 63, wave = __builtin_amdgcn_readfirstlane(tid >> 6);
  char* wsm = smem + wave * 16384;
  bf16_t* Q1 = (bf16_t*)wsm;
  bf16_t* Q2 = (bf16_t*)(wsm + 2048);
  bf16_t* Q3 = (bf16_t*)(wsm + 4096);
  bf16_t* Q4 = (bf16_t*)(wsm + 6144);
  float* F = (float*)(wsm + 8192);
  char* ring0 = P.ring + (size_t)unit * 4 * RSLOT;
  const bf16_t* WT = P.loraT + (size_t)((l * 2 + d) * 6 + h) * 4096;
  const bf16_t* AT = WT + (size_t)24 * 4096;
  const float w0j = P.rwkv_w0[(l * 2 + d) * 384 + h * 64 + lane0];
  const float a0j = P.rwkv_a0[(l * 2 + d) * 384 + h * 64 + lane0];
  const float kkj = P.rwkv_k_k[l * 384 + h * 64 + lane0];
  const float kaj = P.rwkv_k_a[l * 384 + h * 64 + lane0];
  const float rkj = P.rwkv_r_k[((l * 2 + d) * 6 + h) * 64 + lane0];
  f32x4 accS[4];
#pragma unroll
  for (int mt = 0; mt < 4; ++mt) accS[mt] = f32x4{0.f, 0.f, 0.f, 0.f};

  for (int rnd = 0; rnd < 36; ++rnd) {
    int L, base;
    if (rnd < 4) { L = CTXL; base = NLAT + b * CTXL; }
    else { L = SEQL; base = b * SEQL; }
    const int rr0 = (rnd < 4) ? rnd : rnd - 4;
    const int lane = opq(lane0), fr = lane & 15, q = lane >> 4, j = lane;
    const int offA = (j >> 5) * 1024 + ((j >> 2) & 3) * 256 + ((j >> 4) & 1) * 8 + (j & 3) * 2;
    char* ring = ring0;
    asm volatile("" : "+s"(ring));
    char* myslot = ring + wave * RSLOT;
    {
      const int spos = (rr0 * 4 + wave) * 16;
      const int t0 = d ? (L - 1 - spos) : spos;
      const int tlo = d ? (t0 - 15) : t0;
      float rv[16], kv[16], vv[16];
      {
        __amdgpu_buffer_rsrc_t prs = __builtin_amdgcn_make_buffer_rsrc((void*)P.p, 0, 0x7ffffff0, 0x00020000);
        int uc_[5];
        uc_[0] = 1152 + d * 64; uc_[1] = 1280 + d * 64; uc_[2] = h * 64; uc_[3] = 384 + h * 64; uc_[4] = 768 + h * 64;
        const bool vprev = d ? (t0 < L - 1) : (t0 > 0);
        const bool vnext = d ? (t0 - 15 > 0) : (t0 + 15 < L - 1);
        const int tmin = d ? (t0 - 16) : (t0 - 1);
        char* stg = wsm + 4096;
        const int lrow = opq(lane) >> 3, lc8 = lane & 7;
        u32x4 pcs[5][3];
#pragma unroll
        for (int g = 0; g < 5; ++g) {
          const int so = __builtin_amdgcn_readfirstlane((PTOFF(256 + uc_[g]) + (base + tmin) * 128) * 2);
#pragma unroll
          for (int k = 0; k < 3; ++k) {
            const int rr = lrow + 8 * k;
            const int ridx = d ? (17 - rr) : rr;
            pcs[g][k] = u32x4{0u, 0u, 0u, 0u};
            const bool ok = (rr < 18) && !((rr == 0) && !vprev) && !((rr == 17) && !vnext);
            if (ok) pcs[g][k] = __builtin_amdgcn_raw_buffer_load_b128(prs, ridx * 256 + lc8 * 16, so, 0);
          }
        }
#pragma unroll
        for (int g = 0; g < 5; ++g)
#pragma unroll
          for (int k = 0; k < 3; ++k) {
            const int rr = lrow + 8 * k;
            if (rr < 18) *(u32x4*)(stg + (g * 18 + rr) * 128 + lc8 * 16) = pcs[g][k];
          }
        wave_sync();
        bf16_t raw[5][18];
#pragma unroll
        for (int g = 0; g < 5; ++g)
#pragma unroll
          for (int rr = 0; rr < 18; ++rr) raw[g][rr] = *(const bf16_t*)(stg + (g * 18 + rr) * 128 + j * 2);
        wave_sync();
        __builtin_amdgcn_sched_barrier(0);
#pragma unroll
        for (int g = 0; g < 5; ++g) {
          const int uc = uc_[g] + j;
          const float ca = P.rwkv_shift[(l * 3 + 0) * 1408 + uc], c1 = P.rwkv_shift[(l * 3 + 1) * 1408 + uc],
                      cb = P.rwkv_shift[(l * 3 + 2) * 1408 + uc];
          const float cprev = d ? cb : ca, cnext = d ? ca : cb;
#pragma unroll
          for (int i = 0; i < 16; ++i) {
            float val = cprev * bf2f(raw[g][i]) + c1 * bf2f(raw[g][i + 1]) + cnext * bf2f(raw[g][i + 2]);
            if (g == 0) Q1[i * 64 + j] = f2bfh(ftanh(val));
            else if (g == 1) Q2[i * 64 + j] = f2bfh(val);
            else if (g == 2) rv[i] = val;
            else if (g == 3) kv[i] = val;
            else vv[i] = val;
          }
        }
      }
      wave_sync();
      float* G = F + 1024;
#pragma unroll
      for (int nt = 0; nt < 4; ++nt) {
        f32x4 acc = {0.f, 0.f, 0.f, 0.f}, acc2 = acc;
#pragma unroll
        for (int s = 0; s < 2; ++s) {
          bf16x8 a = *(const bf16x8*)(Q1 + fr * 64 + s * 32 + q * 8);
          bf16x8 bw = *(const bf16x8*)(WT + (16 * nt + fr) * 64 + s * 32 + q * 8);
          acc = MFMA32(a, bw, acc);
          bf16x8 a2 = *(const bf16x8*)(Q2 + fr * 64 + s * 32 + q * 8);
          bf16x8 bw2 = *(const bf16x8*)(AT + (16 * nt + fr) * 64 + s * 32 + q * 8);
          acc2 = MFMA32(a2, bw2, acc2);
        }
#pragma unroll
        for (int jj = 0; jj < 4; ++jj) {
          F[(4 * q + jj) * 64 + 16 * nt + fr] = acc[jj];
          G[(4 * q + jj) * 64 + 16 * nt + fr] = acc2[jj];
        }
      }
      wave_sync();
      float kt[16];
      float khv[16], bhv[16];
      {
        float av[16], ssv[16];
        {
          float* R1 = (float*)Q1;
          float* R2 = (float*)Q3;
          float sq[16], bt[16];
#pragma unroll
          for (int i = 0; i < 16; ++i) {
            float a = sigmf(G[i * 64 + j] + a0j);
            av[i] = a;
            float kkv = kv[i] * kkj;
            sq[i] = kkv * kkv;
            bt[i] = rv[i] * (kv[i] * (1.f + (a - 1.f) * kaj)) * rkj;
          }
#pragma unroll
          for (int c4 = 0; c4 < 4; ++c4) {
            *(f32x4*)(R2 + j * 16 + c4 * 4) = f32x4{sq[c4 * 4], sq[c4 * 4 + 1], sq[c4 * 4 + 2], sq[c4 * 4 + 3]};
            *(f32x4*)(R1 + j * 16 + c4 * 4) = f32x4{bt[c4 * 4], bt[c4 * 4 + 1], bt[c4 * 4 + 2], bt[c4 * 4 + 3]};
          }
          wave_sync();
          float s1 = 0.f, s2 = 0.f;
#pragma unroll
          for (int k = 0; k < 16; ++k) {
            s1 += R2[(q * 16 + k) * 16 + fr];
            s2 += R1[(q * 16 + k) * 16 + fr];
          }
          s1 += __shfl_xor(s1, 16); s1 += __shfl_xor(s1, 32);
          s2 += __shfl_xor(s2, 16); s2 += __shfl_xor(s2, 32);
          if (lane < 16) {
            G[lane] = s1;
            const int tb = d ? (t0 - lane) : (t0 + lane);
            P.bonus[(size_t)(base + tb) * 12 + d * 6 + h] = s2;
          }
          wave_sync();
#pragma unroll
          for (int c4 = 0; c4 < 4; ++c4) {
            f32x4 x = *(const f32x4*)(G + c4 * 4);
            ssv[c4 * 4] = x[0]; ssv[c4 * 4 + 1] = x[1]; ssv[c4 * 4 + 2] = x[2]; ssv[c4 * 4 + 3] = x[3];
          }
          wave_sync();
        }
        float g = 0.f, eg = 1.f;
#pragma unroll
        for (int i = 0; i < 16; ++i) {
          float wl = F[i * 64 + j] + w0j;
          float lw = -0.60653066f * frcp(1.f + __expf(-wl));
          const float egp = eg;
          g += lw;
          float a = av[i];
          float kkv = kv[i] * kkj;
          float kk = kkv * __builtin_amdgcn_rsqf(ssv[i] + 1e-12f);
          float kmod = kv[i] * (1.f + (a - 1.f) * kaj);
          float bb = a * kk;
          eg = __expf(g);
          float eng = frcp(eg);
          kt[i] = kk * egp;
          khv[i] = kmod * eng;
          bhv[i] = bb * eng;
          Q1[i * 64 + j] = f2bfh(kt[i]);
          Q2[i * 64 + j] = f2bfh(rv[i] * eg);
          Q3[i * 64 + j] = f2bfh(bhv[i]);
          Q4[i * 64 + j] = f2bfh(khv[i]);
        }
        const float pC = eg;
        GST(float, myslot + 14336 + j * 4, pC);
#pragma unroll
        for (int qq = 0; qq < 4; ++qq) {
          uint4 o;
          o.x = pk2(khv[4 * qq] * pC, khv[4 * qq + 1] * pC);
          o.y = pk2(khv[4 * qq + 2] * pC, khv[4 * qq + 3] * pC);
          o.z = pk2(-bhv[4 * qq] * pC, -bhv[4 * qq + 1] * pC);
          o.w = pk2(-bhv[4 * qq + 2] * pC, -bhv[4 * qq + 3] * pC);
          GST(u32x4, myslot + 4096 + ((q * 64 + qq * 16 + fr) * 16), (u32x4{o.x, o.y, o.z, o.w}));
          uint2 ov;
          ov.x = pk2(vv[4 * qq], vv[4 * qq + 1]);
          ov.y = pk2(vv[4 * qq + 2], vv[4 * qq + 3]);
          GST(u32x2, myslot + 8192 + ((q * 64 + qq * 16 + fr) * 8), (u32x2{ov.x, ov.y}));
        }
        {
          uint4 o0, o1;
          o0.x = pk2(kt[0], kt[1]); o0.y = pk2(kt[2], kt[3]); o0.z = pk2(kt[4], kt[5]); o0.w = pk2(kt[6], kt[7]);
          o1.x = pk2(kt[8], kt[9]); o1.y = pk2(kt[10], kt[11]); o1.z = pk2(kt[12], kt[13]); o1.w = pk2(kt[14], kt[15]);
          *(uint4*)((char*)G + j * 32) = o0;
          *(uint4*)((char*)G + j * 32 + 16) = o1;
          o0.x = pk2(vv[0], vv[1]); o0.y = pk2(vv[2], vv[3]); o0.z = pk2(vv[4], vv[5]); o0.w = pk2(vv[6], vv[7]);
          o1.x = pk2(vv[8], vv[9]); o1.y = pk2(vv[10], vv[11]); o1.z = pk2(vv[12], vv[13]); o1.w = pk2(vv[14], vv[15]);
          *(uint4*)((char*)G + 2048 + j * 32) = o0;
          *(uint4*)((char*)G + 2048 + j * 32 + 16) = o1;
        }
      }
      wave_sync();
      f32x4 aM = {0.f, 0.f, 0.f, 0.f}, aN = aM, aRb = aM, aRk = aM;
#pragma unroll
      for (int s = 0; s < 2; ++s) {
        bf16x8 x1 = *(const bf16x8*)(Q1 + fr * 64 + s * 32 + q * 8);
        bf16x8 x2 = *(const bf16x8*)(Q2 + fr * 64 + s * 32 + q * 8);
        bf16x8 x3 = *(const bf16x8*)(Q3 + fr * 64 + s * 32 + q * 8);
        bf16x8 x4 = *(const bf16x8*)(Q4 + fr * 64 + s * 32 + q * 8);
        aM = MFMA32(x3, x1, aM);
        aN = MFMA32(x4, x1, aN);
        aRb = MFMA32(x3, x2, aRb);
        aRk = MFMA32(x4, x2, aRk);
      }
#pragma unroll
      for (int jj = 0; jj < 4; ++jj) {
        const int ii = 4 * q + jj;
        if (!(ii < fr)) { aM[jj] = 0.f; aN[jj] = 0.f; }
        if (!(ii <= fr)) { aRb[jj] = 0.f; aRk[jj] = 0.f; }
      }
      {
        const int c = lane & 15;
        float tt[16];
#pragma unroll
        for (int t = 0; t < 16; ++t) {
          float acc = (t == c) ? 1.f : 0.f;
#pragma unroll
          for (int i = 0; i < t; ++i) acc -= rlane(aM[i & 3], (i >> 2) * 16 + t) * tt[i];
          tt[t] = acc;
        }
        if (lane < 16) {
#pragma unroll
          for (int t = 0; t < 16; ++t) F[t * 16 + c] = tt[t];
        }
      }
      wave_sync();
      {
        U4 tA, nA, rbA, rkA;
        f32x4 tv = *(const f32x4*)(F + fr * 16 + 4 * q);
        tA.u[0] = pk2(tv[0], tv[1]); tA.u[1] = pk2(tv[2], tv[3]);
        nA.u[0] = pk2(aN[0], aN[1]); nA.u[1] = pk2(aN[2], aN[3]);
        rbA.u[0] = pk2(-aRb[0], -aRb[1]); rbA.u[1] = pk2(-aRb[2], -aRb[3]);
        rkA.u[0] = pk2(aRk[0], aRk[1]); rkA.u[1] = pk2(aRk[2], aRk[3]);
        const f32x4 z4 = {0.f, 0.f, 0.f, 0.f};
#pragma unroll
        for (int nt = 0; nt < 4; ++nt) {
          U4 kB, vB;
          kB.q = *(const uint2*)((const char*)G + (16 * nt + fr) * 32 + 8 * q);
          vB.q = *(const uint2*)((const char*)G + 2048 + (16 * nt + fr) * 32 + 8 * q);
          f32x4 kbar = MFMA16(tA.v, kB.v, z4);
          U4 kbB; kbB.u[0] = pk2(kbar[0], kbar[1]); kbB.u[1] = pk2(kbar[2], kbar[3]);
          f32x4 rtd;
#pragma unroll
          for (int jj = 0; jj < 4; ++jj) rtd[jj] = bf2f(Q2[(4 * q + jj) * 64 + 16 * nt + fr]);
          f32x4 rp = MFMA16(rbA.v, kbB.v, rtd);
          f32x4 nv = MFMA16(nA.v, vB.v, z4);
          U4 nvB; nvB.u[0] = pk2(nv[0], nv[1]); nvB.u[1] = pk2(nv[2], nv[3]);
          f32x4 w2 = MFMA16(tA.v, nvB.v, z4);
          U4 w2B; w2B.u[0] = pk2(w2[0], w2[1]); w2B.u[1] = pk2(w2[2], w2[3]);
          f32x4 yi = MFMA16(rkA.v, vB.v, z4);
          yi = MFMA16(rbA.v, w2B.v, yi);
          const int chan = 16 * nt + fr;
          const int oA = (chan >> 5) * 1024 + ((chan >> 2) & 3) * 256 + ((chan >> 4) & 1) * 8 + (chan & 3) * 2;
#pragma unroll
          for (int jj = 0; jj < 4; ++jj) {
            GST(bf16_t, myslot + oA + (4 * q + jj) * 16, f2bfh(kbar[jj]));
            GST(bf16_t, myslot + 2048 + oA + (4 * q + jj) * 16, f2bfh(rp[jj]));
          }
          GST(u32x2, myslot + 10240 + ((nt * 64 + lane) * 8), (u32x2{w2B.u[0], w2B.u[1]}));
          uint2 yo; yo.x = pk2(yi[0], yi[1]); yo.y = pk2(yi[2], yi[3]);
          GST(u32x2, myslot + 12288 + ((nt * 64 + lane) * 8), (u32x2{yo.x, yo.y}));
        }
      }
    }
    __syncthreads();
    unsigned pfd[2] = {0u, 0u};
    {
      {
        int nr = rnd + 1;
        if (nr < 36) {
          int Ln, basen;
          if (nr < 4) { Ln = CTXL; basen = NLAT + b * CTXL; }
          else { Ln = SEQL; basen = b * SEQL; }
          const int rrn = (nr < 4) ? nr : nr - 4;
          const int sposn = (rrn * 4 + wave) * 16;
          const int t0n = d ? (Ln - 1 - sposn) : sposn;
          const int tlon = d ? (t0n - 15) : t0n;
#pragma unroll
          for (int hlf = 0; hlf < 2; ++hlf) {
            int idx = lane + hlf * 64;
            if (idx < 90) {
              int ga = idx / 18, rr = idx % 18;
              int trow = tlon - 1 + rr;
              int col = (ga == 0) ? (h * 64) : (ga == 1) ? (384 + h * 64) : (ga == 2) ? (768 + h * 64) : (ga == 3) ? (1152 + d * 64) : (1280 + d * 64);
              if (trow >= 0 && trow < Ln) {
                asm volatile("global_load_ubyte %0, %1, off" : "=v"(pfd[hlf]) : "v"(P.p + PT(basen + trow, 256 + col)));
              }
            }
          }
        }
      }
      struct SeqOps { bf16x8 ka0, ka1, ra0, ra1, kb[4]; f32x4 pc[4]; u32x2 vq, w2q, yiq; };
      SeqOps cur, nxt;
#define LOADOPS(O, sc_)                                                          \
  {                                                                               \
    const char* sl = ring + (sc_) * RSLOT;                                        \
    O.ka0 = GLD(bf16x8, sl + lane * 16);                                     \
    O.ka1 = GLD(bf16x8, sl + 1024 + lane * 16);                              \
    O.ra0 = GLD(bf16x8, sl + 2048 + lane * 16);                              \
    O.ra1 = GLD(bf16x8, sl + 3072 + lane * 16);                              \
    _Pragma("unroll") for (int mt = 0; mt < 4; ++mt) {                            \
      O.kb[mt] = GLD(bf16x8, sl + 4096 + (mt * 64 + lane) * 16);             \
      O.pc[mt] = GLD(f32x4, sl + 14336 + (16 * mt + 4 * q) * 4);             \
    }                                                                             \
    O.vq = GLD(u32x2, sl + 8192 + (wave * 64 + lane) * 8);                   \
    O.w2q = GLD(u32x2, sl + 10240 + (wave * 64 + lane) * 8);                 \
    O.yiq = GLD(u32x2, sl + 12288 + (wave * 64 + lane) * 8);                 \
  }
      LOADOPS(cur, 0);
#pragma unroll
      for (int sc = 0; sc < 4; ++sc) {
        if (sc < 3) LOADOPS(nxt, sc + 1);
        bf16x8 B0 = pack8(accS[0], accS[1]);
        bf16x8 B1 = pack8(accS[2], accS[3]);
        f32x4 accU = unpack4(make_uint2(cur.w2q.x, cur.w2q.y));
        accU = MFMA32(cur.ka0, B0, accU);
        accU = MFMA32(cur.ka1, B1, accU);
        f32x4 accY = unpack4(make_uint2(cur.yiq.x, cur.yiq.y));
        accY = MFMA32(cur.ra0, B0, accY);
        accY = MFMA32(cur.ra1, B1, accY);
        U8 z;
        z.u[0] = cur.vq.x; z.u[1] = cur.vq.y;
        z.u[2] = pk2(accU[0], accU[1]); z.u[3] = pk2(accU[2], accU[3]);
#pragma unroll
        for (int mt = 0; mt < 4; ++mt) {
          f32x4 c = accS[mt] * cur.pc[mt];
          accS[mt] = MFMA32(cur.kb[mt], z.v, c);
        }
        const int spos = (rr0 * 4 + sc) * 16;
#pragma unroll
        for (int jj = 0; jj < 4; ++jj) {
          int s = spos + 4 * q + jj;
          int t = d ? (L - 1 - s) : s;
          P.yrec[(size_t)(base + t) * YREC + d * 384 + h * 64 + 16 * wave + fr] = f2bfh(accY[jj]);
        }
        if (sc < 3) cur = nxt;
      }
#undef LOADOPS
    }
    __syncthreads();
    asm volatile("" ::"v"(pfd[0]), "v"(pfd[1]));
  }
}

#define HSLOT 8448
__device__ void hgrn_unit2(const Params& P, int l, int b, int h, int d, char* smem) {
  const int tid = opq(threadIdx.x), lane0 = tid & 63, wave = __builtin_amdgcn_readfirstlane(tid >> 6);
  char* slots = smem;
  char* wsm = smem + 4 * HSLOT + wave * 6144;
  bf16_t* Q1 = (bf16_t*)wsm;
  bf16_t* Q2 = (bf16_t*)(wsm + 2048);
  float* F = (float*)(wsm + 4096);
  char* myslot = slots + wave * HSLOT;
  float lb;
  {
    float x0 = P.hgrn_lb[(d * 2 + 0) * 384 + h * 64 + lane0];
    float x1 = P.hgrn_lb[(d * 2 + 1) * 384 + h * 64 + lane0];
    float mx = fmaxf(x0, x1);
    float e0 = expf(x0 - mx), e1 = expf(x1 - mx);
    float w0 = e0 / (e0 + e1), w1 = e1 / (e0 + e1);
    lb = (l == 0) ? 0.f : fmaxf((w0 + w1) - w0, 0.f);
  }
  f32x4 accS[4];
#pragma unroll
  for (int mt = 0; mt < 4; ++mt) accS[mt] = f32x4{0.f, 0.f, 0.f, 0.f};
  for (int rnd = 0; rnd < 36; ++rnd) {
    int L, base;
    if (rnd < 4) { L = CTXL; base = NLAT + b * CTXL; }
    else { L = SEQL; base = b * SEQL; }
    const int rr0 = (rnd < 4) ? rnd : rnd - 4;
    const int lane = opq(lane0), fr = lane & 15, q = lane >> 4, j = lane;
    const int offA = (j >> 5) * 1024 + ((j >> 2) & 3) * 256 + ((j >> 4) & 1) * 8 + (j & 3) * 2;
    {
      const int spos = (rr0 * 4 + wave) * 16;
      float iv[16], gg[16], kh[16];
      float g = 0.f;
      const int t0 = d ? (L - 1 - spos) : spos;
      const int tlo = d ? (t0 - 15) : t0;
      bf16_t qr[16], ir[16], zr[16];
      {
        __amdgpu_buffer_rsrc_t prs = __builtin_amdgcn_make_buffer_rsrc((void*)P.p, 0, 0x7ffffff0, 0x00020000);
        const int lrow = opq(lane) >> 3, lc8 = lane & 7;
        u32x4 pcs[3][2];
#pragma unroll
        for (int g2 = 0; g2 < 3; ++g2) {
          const int colg = (g2 == 0) ? (1664 + h * 64) : ((g2 == 1) ? (2048 + h * 64) : (2432 + d * 384 + h * 64));
          const int so = __builtin_amdgcn_readfirstlane((PTOFF(colg) + (base + tlo) * 128) * 2);
#pragma unroll
          for (int k = 0; k < 2; ++k) pcs[g2][k] = __builtin_amdgcn_raw_buffer_load_b128(prs, (lrow + 8 * k) * 256 + lc8 * 16, so, 0);
        }
#pragma unroll
        for (int g2 = 0; g2 < 3; ++g2)
#pragma unroll
          for (int k = 0; k < 2; ++k) *(u32x4*)(wsm + (g2 * 16 + lrow + 8 * k) * 128 + lc8 * 16) = pcs[g2][k];
        wave_sync();
#pragma unroll
        for (int i = 0; i < 16; ++i) {
          const int r = d ? (15 - i) : i;
          qr[i] = *(const bf16_t*)(wsm + (0 * 16 + r) * 128 + j * 2);
          ir[i] = *(const bf16_t*)(wsm + (1 * 16 + r) * 128 + j * 2);
          zr[i] = *(const bf16_t*)(wsm + (2 * 16 + r) * 128 + j * 2);
        }
        wave_sync();
      }
#pragma unroll
      for (int i = 0; i < 16; ++i) {
        float qv = bf2f(qr[i]);
        iv[i] = bf2f(ir[i]);
        float z = bf2f(zr[i]);
        float sg = sigmf(z);
        float f = lb + (1.f - lb) * sg;
        float k = (1.f - lb) * (1.f - sg);
        g += __logf(f);
        gg[i] = g;
        kh[i] = k;
        float qt = qv * __expf(g);
        Q1[i * 64 + j] = f2bfh(qt);
        Q2[i * 64 + j] = f2bfh(k * __expf(-g));
        *(bf16_t*)(myslot + offA + i * 16) = f2bfh(qt);
      }
      const float gC = g;
      *(float*)(myslot + 8192 + j * 4) = __expf(gC);
#pragma unroll
      for (int qq = 0; qq < 4; ++qq) {
        uint2 o;
        o.x = pk2(kh[4 * qq] * __expf(gC - gg[4 * qq]), kh[4 * qq + 1] * __expf(gC - gg[4 * qq + 1]));
        o.y = pk2(kh[4 * qq + 2] * __expf(gC - gg[4 * qq + 2]), kh[4 * qq + 3] * __expf(gC - gg[4 * qq + 3]));
        *(uint2*)(myslot + 2048 + ((q * 64 + qq * 16 + fr) * 8)) = o;
        o.x = pk2(iv[4 * qq], iv[4 * qq + 1]);
        o.y = pk2(iv[4 * qq + 2], iv[4 * qq + 3]);
        *(uint2*)(myslot + 4096 + ((q * 64 + qq * 16 + fr) * 8)) = o;
      }
      wave_sync();
      f32x4 aA = {0.f, 0.f, 0.f, 0.f};
#pragma unroll
      for (int s = 0; s < 2; ++s) {
        bf16x8 x1 = *(const bf16x8*)(Q1 + fr * 64 + s * 32 + q * 8);
        bf16x8 x2 = *(const bf16x8*)(Q2 + fr * 64 + s * 32 + q * 8);
        aA = MFMA32(x2, x1, aA);
      }
      wave_sync();
      float oi[16];
#pragma unroll
      for (int t = 0; t < 16; ++t) {
        float o = 0.f;
#pragma unroll
        for (int i = 0; i <= t; ++i) o += rlane(aA[i & 3], (i >> 2) * 16 + t) * iv[i];
        oi[t] = o;
      }
#pragma unroll
      for (int qq = 0; qq < 4; ++qq) {
        uint2 o;
        o.x = pk2(oi[4 * qq], oi[4 * qq + 1]);
        o.y = pk2(oi[4 * qq + 2], oi[4 * qq + 3]);
        *(uint2*)(myslot + 6144 + ((q * 64 + qq * 16 + fr) * 8)) = o;
      }
    }
    __syncthreads();
#pragma unroll 1
    for (int sc = 0; sc < 4; ++sc) {
      const char* sl = slots + sc * HSLOT;
      bf16x8 qa0 = *(const bf16x8*)(sl + lane * 16);
      bf16x8 qa1 = *(const bf16x8*)(sl + 1024 + lane * 16);
      U4 kc[4];
      f32x4 pc[4];
#pragma unroll
      for (int mt = 0; mt < 4; ++mt) {
        kc[mt].q = *(const uint2*)(sl + 2048 + (mt * 64 + lane) * 8);
        pc[mt] = *(const f32x4*)(sl + 8192 + (16 * mt + 4 * q) * 4);
      }
      U4 iq;
      iq.q = *(const uint2*)(sl + 4096 + (wave * 64 + lane) * 8);
      uint2 oiq = *(const uint2*)(sl + 6144 + (wave * 64 + lane) * 8);
      bf16x8 B0 = pack8(accS[0], accS[1]);
      bf16x8 B1 = pack8(accS[2], accS[3]);
      f32x4 accO = unpack4(oiq);
      accO = MFMA32(qa0, B0, accO);
      accO = MFMA32(qa1, B1, accO);
#pragma unroll
      for (int mt = 0; mt < 4; ++mt) {
        f32x4 c = accS[mt] * pc[mt];
        accS[mt] = MFMA16(kc[mt].v, iq.v, c);
      }
      const int spos = (rr0 * 4 + sc) * 16;
#pragma unroll
      for (int jj = 0; jj < 4; ++jj) {
        int s = spos + 4 * q + jj;
        int t = d ? (L - 1 - s) : s;
        P.yrec[(size_t)(base + t) * YREC + 768 + d * 384 + h * 64 + 16 * wave + fr] = f2bfh(accO[jj]);
      }
    }
    asm volatile("s_waitcnt lgkmcnt(0)\n\ts_barrier" ::: "memory");
  }
}

__device__ void mix_tile(const Params& P, int l, int tile, float* sm, int part) {
  const int tid = opq(threadIdx.x), lane = tid & 63, wave = __builtin_amdgcn_readfirstlane(tid >> 6);
  int base, segbase, n, tloc0, L, seq0;
  if (tile < 512) { base = tile * 64; segbase = base; n = 64; tloc0 = 0; L = SEQL; seq0 = (tile >> 5) * SEQL; }
  else {
    int ct = tile - 512;
    int b = ct >> 2;
    tloc0 = (ct & 3) * 64;
    segbase = NLAT + b * CTXL;
    base = segbase + tloc0;
    n = CTXL; L = CTXL; seq0 = segbase;
  }
  float* spv = sm;
  float* spT = sm + 80 * 64;
  float* spw = spT + 64 * 68;
  if (part & 1)
  for (int g = 0; g < 4; ++g) {
    int win = 2 << g, left = win >> 1, right = win - 1 - left;
    {
      float vals[20];
#pragma unroll
      for (int k = 0; k < 20; ++k) {
        int e = tid + k * 256;
        int ii = e >> 6, cch = e & 63;
        int tt = tloc0 - 8 + ii;
        vals[k] = (tt >= 0 && tt < n) ? bf2f(P.p[PT(segbase + tt, g * 64 + cch)]) : 0.f;
      }
      f32x4 wv[4];
#pragma unroll
      for (int k = 0; k < 4; ++k) wv[k] = *(const f32x4*)(P.pool_w + (size_t)(l * 4 + g) * 4096 + (tid + k * 256) * 4);
#pragma unroll
      for (int k = 0; k < 20; ++k) spv[tid + k * 256] = vals[k];
#pragma unroll
      for (int k = 0; k < 4; ++k) *(f32x4*)(spw + (tid + k * 256) * 4) = wv[k];
    }
    __syncthreads();
    for (int e = tid; e < 4096; e += 256) {
      int i = e >> 6, cch = e & 63;
      int t = tloc0 + i;
      int lo = max(t - left, 0), hi = min(t + right, n - 1) + 1;
      float s = 0.f;
      for (int tt = lo; tt < hi; ++tt) s += spv[(tt - tloc0 + 8) * 64 + cch];
      spT[cch * 68 + i] = s * frcp((float)(hi - lo)) - spv[(i + 8) * 64 + cch];
    }
    __syncthreads();
    const int col = g * 64 + lane;
    float gatev[16];
#pragma unroll
    for (int r = 0; r < 16; ++r) gatev[r] = bf2f(P.p[PT(base + wave * 16 + r, 3200 + col)]);
    float acc[16];
#pragma unroll
    for (int r = 0; r < 16; ++r) acc[r] = 0.f;
#pragma unroll 4
    for (int cch = 0; cch < 64; ++cch) {
      float w = spw[cch * 64 + lane];
      const f32x4* tp = (const f32x4*)(spT + cch * 68 + wave * 16);
      f32x4 t0 = tp[0], t1 = tp[1], t2 = tp[2], t3 = tp[3];
#pragma unroll
      for (int e = 0; e < 4; ++e) {
        acc[e] += t0[e] * w; acc[4 + e] += t1[e] * w; acc[8 + e] += t2[e] * w; acc[12 + e] += t3[e] * w;
      }
    }
    float psc = P.pool_scale[l * 256 + col];
#pragma unroll
    for (int r = 0; r < 16; ++r) {
      int token = base + wave * 16 + r;
      P.xn[XT(token, col)] = f2bf(acc[r] * psc * siluf(gatev[r]));
    }
    __syncthreads();
  }
  if (part & 2) {
    const int grp = lane >> 4, c4 = (lane & 15) * 4;
#pragma unroll 1
    for (int pass = 0; pass < 3; ++pass) {
      const int hh = pass * 4 + grp;
      const bool isr = hh < 6;
      const int ch = (isr ? hh : hh - 6) * 64 + c4;
      const int uc = 768 + ch;
      const int oya = isr ? ch : 768 + ch, oyb = isr ? 384 + ch : 1152 + ch;
      const int ogate = 3200 + (isr ? 256 : 640) + ch, omix = (isr ? 256 : 640) + ch;
      f32x4 s0 = {0.f, 0.f, 0.f, 0.f}, s1 = s0, s2 = s0, gg = s0, gb = s0;
      if (isr) {
        s0 = *(const f32x4*)(P.rwkv_shift + (l * 3 + 0) * 1408 + uc);
        s1 = *(const f32x4*)(P.rwkv_shift + (l * 3 + 1) * 1408 + uc);
        s2 = *(const f32x4*)(P.rwkv_shift + (l * 3 + 2) * 1408 + uc);
        gg = *(const f32x4*)(P.rwkv_gn_g + l * 384 + ch);
        gb = *(const f32x4*)(P.rwkv_gn_b + l * 384 + ch);
      } else {
        gg = *(const f32x4*)(P.hgrn_norm_g + l * 384 + ch);
      }
#pragma unroll 1
      for (int r0 = 0; r0 < 16; r0 += 4) {
        uint2 ya[4], yb[4], vm[4], vl[4], vh[4], gt[4];
        float bon[4];
#pragma unroll
        for (int u = 0; u < 4; ++u) {
          const int token = base + wave * 16 + r0 + u;
          const int t = token - seq0;
          const bf16_t* yr = P.yrec + (size_t)token * YREC;
          ya[u] = *(const uint2*)(yr + oya);
          yb[u] = *(const uint2*)(yr + oyb);
          gt[u] = *(const uint2*)(P.p + PT(token, ogate));
          vm[u] = make_uint2(0u, 0u); vl[u] = vm[u]; vh[u] = vm[u]; bon[u] = 0.f;
          if (isr) {
            bon[u] = P.bonus[(size_t)token * 12 + hh] + P.bonus[(size_t)token * 12 + 6 + hh];
            const bf16_t* pv = P.p + PT(token, 256 + uc);
            vm[u] = *(const uint2*)pv;
            if (t > 0) vl[u] = *(const uint2*)(pv - 128);
            if (t < L - 1) vh[u] = *(const uint2*)(pv + 128);
          }
        }
#pragma unroll
        for (int u = 0; u < 4; ++u) {
          const int token = base + wave * 16 + r0 + u;
          f32x4 y = unpack4(ya[u]) + unpack4(yb[u]);
          f32x4 gate = unpack4(gt[u]);
          f32x4 o;
          if (isr) {
            float mu = rsum16(y[0] + y[1] + y[2] + y[3]) * (1.f / 64.f);
            f32x4 dl = y - mu;
            float var = rsum16(dl[0] * dl[0] + dl[1] * dl[1] + dl[2] * dl[2] + dl[3] * dl[3]) * (1.f / 64.f);
            float rs = __builtin_amdgcn_rsqf(var + GN_EPS_F);
            f32x4 v = s1 * unpack4(vm[u]) + s0 * unpack4(vl[u]) + s2 * unpack4(vh[u]);
#pragma unroll
            for (int e = 0; e < 4; ++e) o[e] = (dl[e] * rs * gg[e] + gb[e] + bon[u] * v[e]) * siluf(gate[e]);
          } else {
            float ms = rsum16(y[0] * y[0] + y[1] * y[1] + y[2] * y[2] + y[3] * y[3]) * (1.f / 64.f);
            float rs = __builtin_amdgcn_rsqf(ms + RMS_EPS_F);
#pragma unroll
            for (int e = 0; e < 4; ++e) o[e] = y[e] * rs * gg[e] * siluf(gate[e]);
          }
          uint2 ov;
          ov.x = pk2(o[0], o[1]); ov.y = pk2(o[2], o[3]);
          *(uint2*)(P.xn + XT(token, omix)) = ov;
        }
      }
    }
  }
}

#define XB_TMO      128
#define XB_XCNT(j)  (256  + 64 * (j))
#define XB_XSUB(j)  (1280 + 64 * (j))
#define XB_XGEN(j)  (2304 + 64 * (j))
#define XB_TOP      3328
#define XB_TOPGEN   3392
#define XCD_BAR_WORDS 3456
#define XB_SPIN_CAP (1u << 18)
__device__ __forceinline__ unsigned xb_ld(unsigned* p) { return __hip_atomic_load(p, __ATOMIC_RELAXED, __HIP_MEMORY_SCOPE_AGENT); }
__device__ __forceinline__ unsigned xb_add(unsigned* p, unsigned v) { return __hip_atomic_fetch_add(p, v, __ATOMIC_RELAXED, __HIP_MEMORY_SCOPE_AGENT); }
__device__ __forceinline__ unsigned xb_xcc_id() { return (unsigned)__builtin_amdgcn_s_getreg((3 << 11) | 20) & 0xFu; }
#define XB_SPIN(cond, bar) do { unsigned _sp = 0; while (cond) { __builtin_amdgcn_s_sleep(1); \
    if ((++_sp & 255u) == 0u) { if (xb_ld(&(bar)[XB_TMO])) break; if (_sp > XB_SPIN_CAP) { atomicAdd(&(bar)[XB_TMO], 1u); break; } } } } while (0)
__device__ __forceinline__ void xcd_barrier(unsigned* bar, unsigned x, unsigned nloc, unsigned nx) {
  asm volatile("s_waitcnt vmcnt(0)" ::: "memory");
  __syncthreads();
  if (threadIdx.x == 0) {
    __builtin_amdgcn_s_waitcnt(0);
    const unsigned old = xb_add(&bar[XB_XSUB(x)], 1u);
    const unsigned gen = old / nloc;
    if (old + 1u == (gen + 1u) * nloc) {
      __builtin_amdgcn_fence(__ATOMIC_RELEASE, "agent");
      asm volatile("s_waitcnt vmcnt(0)" ::: "memory");
      const unsigned og = xb_add(&bar[XB_TOP], 1u);
      const unsigned tg = og / nx;
      if (og + 1u == (tg + 1u) * nx) xb_add(&bar[XB_TOPGEN], 1u);
      else XB_SPIN(xb_ld(&bar[XB_TOPGEN]) == tg, bar);
      __builtin_amdgcn_fence(__ATOMIC_ACQUIRE, "agent");
      xb_add(&bar[XB_XGEN(x)], 1u);
      asm volatile("s_waitcnt vmcnt(0)" ::: "memory");
    } else {
      XB_SPIN(xb_ld(&bar[XB_XGEN(x)]) == gen, bar);
      __builtin_amdgcn_fence(__ATOMIC_ACQUIRE, "agent");
      asm volatile("s_waitcnt vmcnt(0)" ::: "memory");
    }
  }
  __syncthreads();
}

__device__ void p0_unit(const Params& P, int u, float* smf) {
  if (u < 2 * 1056) {
    int l = u / 1056, r = u % 1056;
    transpose_tile(P.w_in + (size_t)l * 1024 * DIN, DIN, P.WtIn + (size_t)l * DIN * 1024, r / 66, r % 66, smf);
  } else if (u < 2 * 1056 + 2 * 256) {
    int v = u - 2 * 1056;
    int l = v / 256, r = v % 256;
    transpose_tile(P.w_out + (size_t)l * 1024 * 1024, 1024, P.WtOut + (size_t)l * 1024 * 1024, r / 16, r % 16, smf);
  } else if (u < 2 * 1056 + 512 + 384) {
    int v = u - 2 * 1056 - 512;
    mod_unit(P, v / 192, v % 192, smf);
  } else {
    int v = u - 2 * 1056 - 512 - 384;
    int which = v / 24, r = v % 24;
    const float* src = (which ? P.rwkv_a_up : P.rwkv_w_up) + (size_t)(r / 6) * 64 * 384 + (r % 6) * 64;
    bf16_t* dst = P.loraT + (size_t)v * 4096;
    for (int e = opq(threadIdx.x); e < 4096; e += 256) {
      int jj = e >> 6, m = e & 63;
      dst[e] = f2bf(src[m * 384 + jj]);
    }
    __syncthreads();
  }
}

__global__ void __launch_bounds__(256, 2) fwd_megakernel(Params P) {
  cg::grid_group grid = cg::this_grid();
  __shared__ __attribute__((aligned(16))) char smem[SMEM_BYTES];
  float* smf = (float*)smem;
  const int bid = blockIdx.x, nblk = gridDim.x;
  const unsigned xcc = xb_xcc_id();
  if (threadIdx.x == 0) *(unsigned*)smem = xb_add(&P.bar[XB_XCNT(xcc)], 1u);
  __syncthreads();
  const int xslot = __builtin_amdgcn_readfirstlane(*(const unsigned*)smem);
  __syncthreads();

  const bool defer_p0 = nblk > 384;
  for (int rep = 0; rep < REP_P0; ++rep) {
    if (defer_p0) {
      for (int e = bid; e < 1272; e += nblk) {
        int u;
        if (e < 192) u = 2624 + e;
        else if (e < 216) { int le = e - 192; u = 3008 + (le / 12) * 24 + (le % 12); }
        else u = e - 216;
        p0_unit(P, u, smf);
      }
    } else {
      for (int u = bid; u < 3056; u += nblk) p0_unit(P, u, smf);
    }
  }
  if (gridDim.x == 0x7fffffffu) grid.sync();
  unsigned nloc = 0u, nxc = 0u, nlow = 0u;
  {
    __syncthreads();
    if (threadIdx.x == 0) {
      unsigned sp = 0u, a = 0u, bq = 0u, cq = 0u;
      for (;;) {
        unsigned sum = 0u;
        a = 0u; bq = 0u; cq = 0u;
#pragma unroll
        for (unsigned jx = 0; jx < 16; ++jx) {
          const unsigned c = xb_ld(&P.bar[XB_XCNT(jx)]);
          sum += c;
          bq += (c > 0u) ? 1u : 0u;
          cq += (jx < 8u && c > 0u) ? 1u : 0u;
          a = (jx == xcc) ? c : a;
        }
        if (sum == gridDim.x) break;
        __builtin_amdgcn_s_sleep(1);
        if ((++sp & 255u) == 0u) { if (xb_ld(&P.bar[XB_TMO])) break; if (sp > XB_SPIN_CAP) { atomicAdd(&P.bar[XB_TMO], 1u); break; } }
      }
      ((unsigned*)smem)[0] = a; ((unsigned*)smem)[1] = bq; ((unsigned*)smem)[2] = cq;
    }
    __syncthreads();
    nloc = ((const unsigned*)smem)[0]; nxc = ((const unsigned*)smem)[1]; nlow = ((const unsigned*)smem)[2];
    __syncthreads();
    nlow = __builtin_amdgcn_readfirstlane(nlow);
    nloc = __builtin_amdgcn_readfirstlane(nloc > 0u ? nloc : 1u);
    nxc = __builtin_amdgcn_readfirstlane(nxc > 0u ? nxc : 1u);
  }
  xcd_barrier(P.bar, xcc, nloc, nxc);

  for (int l = 0; l < 2; ++l) {
    ln_phase(P, l);
    xcd_barrier(P.bar, xcc, nloc, nxc);
    for (int rep = 0; rep < REP_G1; ++rep) {
      if (nxc == 8u && nlow == 8u) {
        const int xcd = (int)xcc, slot = xslot, nslot = (int)nloc;
        for (int i = slot; i < 36 * 33; i += nslot) {
          int mg = i / 132, r = i % 132;
          int nt = r >> 2, mt = xcd * 36 + mg * 4 + (r & 3);
          gemm_tile<0>(P, l, P.xn, P.WtIn + (size_t)l * DIN * 1024, mt * 128, nt * 128, smem);
        }
      } else {
        for (int t = bid; t < 288 * 33; t += nblk) {
          int mt = t / 33, nt = t % 33;
          gemm_tile<0>(P, l, P.xn, P.WtIn + (size_t)l * DIN * 1024, mt * 128, nt * 128, smem);
        }
      }
    }
    xcd_barrier(P.bar, xcc, nloc, nxc);
    const bool grid512 = (nblk == 512);
    int sidx = -1, nside = 0;
    if (grid512) { nside = 128; sidx = (bid >= 192 && bid < 256) ? (bid - 192) : ((bid >= 448) ? (64 + bid - 448) : -1); }
    else if (nblk > 384) { nside = nblk - 384; sidx = (bid >= 384) ? (bid - 384) : -1; }
    for (int rep = 0; rep < REP_SCAN; ++rep)
    for (int u0 = bid; u0 < (grid512 ? 512 : 384); u0 += nblk) {
      int u = u0;
      if (grid512) {
        if (u0 < 192) u = u0;
        else if (u0 >= 256 && u0 < 448) u = 192 + (u0 - 256);
        else continue;
      }
      int type = u / 192, rem = u % 192;
      int d = rem / 96, b = (rem % 96) / 6, h = rem % 6;
      if (type == 0) rwkv_unit2(P, l, b, h, d, smem, rem);
      else hgrn_unit2(P, l, b, h, d, smem);
    }
    const bool pool_in_scan = nblk > 384;
    if (pool_in_scan && sidx >= 0) {
      const int ntile_p = (l == 0) ? 576 : 512;
      for (int t = sidx; t < ntile_p; t += nside) mix_tile(P, l, t, smf, 1);
      if (l == 0) {
        for (int f = sidx; f < 1784; f += nside) {
          int u;
          if (f < 1056) u = 1056 + f;
          else if (f < 1568) u = 2112 + (f - 1056);
          else if (f < 1760) u = 2624 + 192 + (f - 1568);
          else { int lf = f - 1760; u = 3008 + (lf / 12) * 24 + 12 + (lf % 12); }
          p0_unit(P, u, smf);
        }
      }
    }
    xcd_barrier(P.bar, xcc, nloc, nxc);
    {
      int ntile = (l == 0) ? 576 : 512;
      for (int rep = 0; rep < REP_MIX; ++rep)
      for (int t = bid; t < ntile; t += nblk) mix_tile(P, l, t, smf, (nblk > 384) ? 2 : 3);
    }
    xcd_barrier(P.bar, xcc, nloc, nxc);
    {
      int nmt = (l == 0) ? 288 : 256;
      for (int rep = 0; rep < ((l == 0) ? REP_G2 : 1); ++rep) {
        if (nxc == 8u && nlow == 8u) {
          const int xcd = (int)xcc, slot = xslot, nslot = (int)nloc, mpx = nmt >> 3;
          for (int i = slot; i < mpx * 8; i += nslot) {
            int mt = xcd * mpx + (i >> 3), nt = i & 7;
            gemm_tile<1>(P, l, P.xn, P.WtOut + (size_t)l * 1024 * 1024, mt * 128, nt * 128, smem);
          }
        } else {
          for (int t = bid; t < nmt * 8; t += nblk) {
            int mt = t / 8, nt = t % 8;
            gemm_tile<1>(P, l, P.xn, P.WtOut + (size_t)l * 1024 * 1024, mt * 128, nt * 128, smem);
          }
        }
      }
    }
    xcd_barrier(P.bar, xcc, nloc, nxc);
  }
  final_ln_phase(P);
}

extern "C" void kernel_launch(void* const* d_in, const int* in_sizes, int n_in, void* d_out, int out_size, void* d_ws,
                              size_t ws_size, hipStream_t stream) {
  static int grid_blocks = 0;
  if (!grid_blocks) {
    int dev = 0, cus = 0, per_cu = 0;
    hipGetDevice(&dev);
    hipDeviceGetAttribute(&cus, hipDeviceAttributeMultiprocessorCount, dev);
    hipOccupancyMaxActiveBlocksPerMultiprocessor(&per_cu, fwd_megakernel, 256, 0);
    if (per_cu > 2) per_cu = 2;
    grid_blocks = cus * per_cu;
  }
  Params p{};
  const float* const* in = (const float* const*)d_in;
  p.x = in[0]; p.c = in[1]; p.ctx = in[2]; p.c_ctx = in[3]; p.mod_w = in[4]; p.mod_b = in[5]; p.w_in = in[6];
  p.rwkv_shift = in[7]; p.pool_w = in[8]; p.pool_scale = in[9]; p.rwkv_w0 = in[10]; p.rwkv_w_up = in[11];
  p.rwkv_a0 = in[12]; p.rwkv_a_up = in[13]; p.rwkv_k_k = in[14]; p.rwkv_k_a = in[15]; p.rwkv_r_k = in[16];
  p.rwkv_gn_g = in[17]; p.rwkv_gn_b = in[18]; p.hgrn_lb = in[19]; p.hgrn_norm_g = in[20]; p.w_out = in[21];
  p.ln_g = in[22]; p.ln_b = in[23];
  p.out = (float*)d_out;
  char* ws = (char*)d_ws;
  size_t off = 0;
  auto take = [&](size_t bytes) { char* r = ws + off; off += (bytes + 255) & ~(size_t)255; return r; };
  p.WtIn = (bf16_t*)take((size_t)2 * DIN * 1024 * 2);
  p.WtOut = (bf16_t*)take((size_t)2 * 1024 * 1024 * 2);
  p.mod = (float*)take((size_t)2 * 17 * 3072 * 4);
  p.xn = (bf16_t*)take((size_t)NTOK * 1024 * 2);
  p.p = (bf16_t*)take((size_t)NTOK * DIN * 2);
  p.yrec = (bf16_t*)take((size_t)NTOK * YREC * 2);
  p.bonus = (float*)take((size_t)NTOK * 12 * 4);
  p.loraT = (bf16_t*)take((size_t)48 * 4096 * 2);
  p.ring = take((size_t)192 * 4 * RSLOT);
  p.bar = (unsigned*)take((size_t)XCD_BAR_WORDS * 4);
  p.hprectx = (float*)p.p;
  if (off > ws_size) { fprintf(stderr, "workspace too small: need %zu have %zu\n", off, ws_size); return; }
  hipMemsetAsync(p.bar, 0, (size_t)XCD_BAR_WORDS * 4, stream);
  void* args[] = {&p};
  hipError_t e = hipLaunchCooperativeKernel((void*)fwd_megakernel, dim3(grid_blocks), dim3(256), args, 0, stream);
  if (e != hipSuccess) fprintf(stderr, "cooperative launch failed: %s (grid %d)\n", hipGetErrorString(e), grid_blocks);
}
```

```cpp
#include <hip/hip_runtime.h>
#include <hip/hip_bf16.h>
#include <hip/hip_cooperative_groups.h>
#include <cstdio>
namespace cg = cooperative_groups;

typedef unsigned short bf16_t;
using bf16x8 = __attribute__((ext_vector_type(8))) short;
using f32x4 = __attribute__((ext_vector_type(4))) float;
using u32x4 = __attribute__((ext_vector_type(4))) unsigned;

#define DM 1024
#define NB 16
#define SEQL 2048
#define CTXL 256
#define NLAT 32768
#define NCTX 4096
#define NTOK 36864
#define DIN 4224
#define ALPHA_F 1.4142135623730951f
#define LN_EPS_F 1e-5f
#define GN_EPS_F 64e-5f
#define RMS_EPS_F 1e-6f
#define YREC 1536
#define PTOFF(col) ((((col) >> 7) * NTOK) * 128 + ((col) & 127))
#define PT(tok, col) ((size_t)PTOFF(col) + (size_t)(tok) * 128)
#define XT(row, k) ((size_t)(((k) >> 6) * NTOK + (row)) * 64 + ((k) & 63))
#define SMEM_BYTES 65536
#ifndef REP_P0
#define REP_P0 1
#endif
#ifndef REP_LN
#define REP_LN 1
#endif
#ifndef REP_G1
#define REP_G1 1
#endif
#ifndef REP_SCAN
#define REP_SCAN 1
#endif
#ifndef REP_MIX
#define REP_MIX 1
#endif
#ifndef REP_G2
#define REP_G2 1
#endif

struct Params {
  const float *x, *c, *ctx, *c_ctx, *mod_w, *mod_b, *w_in, *rwkv_shift, *pool_w, *pool_scale,
      *rwkv_w0, *rwkv_w_up, *rwkv_a0, *rwkv_a_up, *rwkv_k_k, *rwkv_k_a, *rwkv_r_k, *rwkv_gn_g, *rwkv_gn_b,
      *hgrn_lb, *hgrn_norm_g, *w_out, *ln_g, *ln_b;
  float* out;
  bf16_t *WtIn, *WtOut, *xn, *p, *yrec;
  float *mod, *bonus, *hprectx;
  bf16_t* loraT;
  char* ring;
  unsigned* bar;
};

__device__ __forceinline__ float bf2f(bf16_t v) { return __uint_as_float(((unsigned)v) << 16); }
__device__ __forceinline__ bf16_t f2bf(float f) {
  unsigned u = __float_as_uint(f);
  u += 0x7fffu + ((u >> 16) & 1u);
  return (bf16_t)(u >> 16);
}
#define DPPF(v, ctrl) __builtin_bit_cast(float, __builtin_amdgcn_update_dpp(0, __builtin_bit_cast(int, (v)), (ctrl), 0xf, 0xf, true))
__device__ __forceinline__ float rsum16(float v) {
  v += DPPF(v, 0xB1);
  v += DPPF(v, 0x4E);
  v += DPPF(v, 0x141);
  v += DPPF(v, 0x140);
  return v;
}
__device__ __forceinline__ float wsum(float v) {
  v = rsum16(v);
  int iv = __builtin_bit_cast(int, v);
  float a = __builtin_bit_cast(float, __builtin_amdgcn_readlane(iv, 0));
  float b = __builtin_bit_cast(float, __builtin_amdgcn_readlane(iv, 16));
  float c = __builtin_bit_cast(float, __builtin_amdgcn_readlane(iv, 32));
  float d = __builtin_bit_cast(float, __builtin_amdgcn_readlane(iv, 48));
  return (a + b) + (c + d);
}
__device__ __forceinline__ int opq(int v) { asm volatile("" : "+v"(v)); return v; }
__device__ __forceinline__ float frcp(float x) { return __builtin_amdgcn_rcpf(x); }
__device__ __forceinline__ float siluf(float x) { return x * frcp(1.f + __expf(-x)); }
__device__ __forceinline__ float sigmf(float x) { return frcp(1.f + __expf(-x)); }
__device__ __forceinline__ float ftanh(float x) { return 1.f - 2.f * frcp(1.f + __expf(2.f * x)); }

__device__ void transpose_tile(const float* __restrict__ W, int N, bf16_t* __restrict__ Wt, int kt, int nt, float* sm) {
  int tid = opq(threadIdx.x);
  {
    float vals[16];
#pragma unroll
    for (int k = 0; k < 16; ++k) {
      int e = tid + k * 256;
      int kk = e >> 6, nn = e & 63;
      vals[k] = W[(size_t)(kt * 64 + kk) * N + nt * 64 + nn];
    }
#pragma unroll
    for (int k = 0; k < 16; ++k) {
      int e = tid + k * 256;
      sm[(e >> 6) * 65 + (e & 63)] = vals[k];
    }
  }
  __syncthreads();
  for (int e = tid; e < 4096; e += 256) {
    int nn = e >> 6, kk = e & 63;
    Wt[((size_t)kt * N + nt * 64 + nn) * 64 + kk] = f2bf(sm[kk * 65 + nn]);
  }
  __syncthreads();
}

__device__ void mod_unit(const Params& P, int l, int cb, float* sm) {
  int tid = opq(threadIdx.x), j = tid & 15, kp = tid >> 4;
  float acc[17];
#pragma unroll
  for (int r = 0; r < 17; ++r) acc[r] = 0.f;
  const float* W = P.mod_w + (size_t)l * 1024 * 3072 + cb * 16 + j;
  for (int pass = 0; pass < 2; ++pass) {
    for (int e = tid; e < 17 * 512; e += 256) {
      int r = e >> 9, k = (e & 511) + pass * 512;
      float v = (r < 16) ? P.c[r * 1024 + k] : P.c_ctx[k];
      sm[e] = siluf(v);
    }
    __syncthreads();
    {
      const int k0 = kp * 32;
      float wv[32];
#pragma unroll
      for (int u = 0; u < 32; ++u) wv[u] = W[(size_t)(pass * 512 + k0 + u) * 3072];
#pragma unroll
      for (int u = 0; u < 32; ++u) {
#pragma unroll
        for (int r = 0; r < 17; ++r) acc[r] += sm[r * 512 + k0 + u] * wv[u];
      }
    }
    __syncthreads();
  }
#pragma unroll
  for (int r = 0; r < 17; ++r) sm[(kp * 17 + r) * 16 + j] = acc[r];
  __syncthreads();
  for (int e = tid; e < 17 * 16; e += 256) {
    int r = e >> 4, jj = e & 15;
    float s0 = 0.f;
#pragma unroll
    for (int k = 0; k < 16; ++k) s0 += sm[(k * 17 + r) * 16 + jj];
    int col = cb * 16 + jj;
    P.mod[((size_t)l * 17 + r) * 3072 + col] = s0 + P.mod_b[l * 3072 + col];
  }
  __syncthreads();
}

__device__ __forceinline__ void ln16(float (&v)[16]) {
  float s = 0.f;
#pragma unroll
  for (int i = 0; i < 16; ++i) s += v[i];
  float mu = wsum(s) * (1.f / 1024.f);
  float q = 0.f;
#pragma unroll
  for (int i = 0; i < 16; ++i) { v[i] -= mu; q += v[i] * v[i]; }
  float rs = rsqrtf(wsum(q) * (1.f / 1024.f) + LN_EPS_F);
#pragma unroll
  for (int i = 0; i < 16; ++i) v[i] *= rs;
}

__device__ void ln_phase(const Params& P, int l) {
  const int tidq = opq(threadIdx.x);
  int lane = tidq & 63;
  int gw = (blockIdx.x * 256 + tidq) >> 6, nw = (gridDim.x * 256) >> 6;
#pragma unroll 2
  for (int row = gw; row < NTOK; row += nw) {
    const float* src;
    int r;
    if (row < NLAT) { src = (l == 0 ? P.x : P.out) + (size_t)row * 1024; r = row >> 11; }
    else { src = (l == 0 ? P.ctx : P.hprectx) + (size_t)(row - NLAT) * 1024; r = 16; }
    float v[16];
#pragma unroll
    for (int i = 0; i < 4; ++i) {
      float4 t = *(const float4*)(src + i * 256 + lane * 4);
      v[i * 4] = t.x; v[i * 4 + 1] = t.y; v[i * 4 + 2] = t.z; v[i * 4 + 3] = t.w;
    }
    if (l > 0) {
      ln16(v);
#pragma unroll
      for (int i = 0; i < 4; ++i) {
        float4 g = *(const float4*)(P.ln_g + (l - 1) * 1024 + i * 256 + lane * 4);
        float4 bb = *(const float4*)(P.ln_b + (l - 1) * 1024 + i * 256 + lane * 4);
        v[i * 4] = v[i * 4] * g.x + bb.x; v[i * 4 + 1] = v[i * 4 + 1] * g.y + bb.y;
        v[i * 4 + 2] = v[i * 4 + 2] * g.z + bb.z; v[i * 4 + 3] = v[i * 4 + 3] * g.w + bb.w;
      }
      if (row < NLAT) {
#pragma unroll
        for (int i = 0; i < 4; ++i)
          *(float4*)(P.out + (size_t)row * 1024 + i * 256 + lane * 4) = make_float4(v[i * 4], v[i * 4 + 1], v[i * 4 + 2], v[i * 4 + 3]);
      }
    }
    ln16(v);
    const float* md = P.mod + ((size_t)l * 17 + r) * 3072;
#pragma unroll
    for (int i = 0; i < 4; ++i) {
      float4 sh = *(const float4*)(md + i * 256 + lane * 4);
      float4 sc = *(const float4*)(md + 1024 + i * 256 + lane * 4);
      ushort4 o;
      o.x = f2bf(v[i * 4] * (1.f + sc.x) + sh.x);
      o.y = f2bf(v[i * 4 + 1] * (1.f + sc.y) + sh.y);
      o.z = f2bf(v[i * 4 + 2] * (1.f + sc.z) + sh.z);
      o.w = f2bf(v[i * 4 + 3] * (1.f + sc.w) + sh.w);
      *(ushort4*)(P.xn + XT(row, i * 256 + lane * 4)) = o;
    }
  }
}

__device__ void final_ln_phase(const Params& P) {
  const int tidq = opq(threadIdx.x);
  int lane = tidq & 63;
  int gw = (blockIdx.x * 256 + tidq) >> 6, nw = (gridDim.x * 256) >> 6;
  for (int row = gw; row < NLAT; row += nw) {
    float* src = P.out + (size_t)row * 1024;
    float v[16];
#pragma unroll
    for (int i = 0; i < 4; ++i) {
      float4 t = *(const float4*)(src + i * 256 + lane * 4);
      v[i * 4] = t.x; v[i * 4 + 1] = t.y; v[i * 4 + 2] = t.z; v[i * 4 + 3] = t.w;
    }
    ln16(v);
#pragma unroll
    for (int i = 0; i < 4; ++i) {
      float4 g = *(const float4*)(P.ln_g + 1024 + i * 256 + lane * 4);
      float4 bb = *(const float4*)(P.ln_b + 1024 + i * 256 + lane * 4);
      *(float4*)(src + i * 256 + lane * 4) = make_float4(v[i * 4] * g.x + bb.x, v[i * 4 + 1] * g.y + bb.y,
                                                          v[i * 4 + 2] * g.z + bb.z, v[i * 4 + 3] * g.w + bb.w);
    }
  }
}

typedef __bf16 bf2e_t __attribute__((ext_vector_type(2)));
typedef float fl2e_t __attribute__((ext_vector_type(2)));
__device__ __forceinline__ unsigned pk2(float a, float b) {
  fl2e_t f = {a, b};
  bf2e_t h = __builtin_convertvector(f, bf2e_t);
  return __builtin_bit_cast(unsigned, h);
}
template <int MODE>
__device__ void gemm_tile(const Params& P, int l, const bf16_t* __restrict__ A, const bf16_t* __restrict__ Bt,
                          int row0, int col0, char* smem) {
  const int tid = opq(threadIdx.x), lane = tid & 63, wave = tid >> 6, wr = wave >> 1, wc = wave & 1, fr = lane & 15, fq = lane >> 4;
  f32x4 acc[4][4];
#pragma unroll
  for (int m = 0; m < 4; ++m)
#pragma unroll
    for (int n = 0; n < 4; ++n) acc[m][n] = f32x4{0.f, 0.f, 0.f, 0.f};
  u32x4 ra0[4], rb0[4], ra1[4], rb1[4];
  const int crow = tid >> 3, c16 = tid & 7;
  const int NBR = (MODE == 0) ? DIN : 1024;
  const bf16_t* Ag = A + (size_t)(row0 + crow) * 64 + c16 * 8;
  const bf16_t* Bg = Bt + (size_t)(col0 + crow) * 64 + c16 * 8;
#define GLOAD(RA, RB, kt)                                                                           \
  _Pragma("unroll") for (int i = 0; i < 4; ++i) {                                                   \
    asm volatile("global_load_dwordx4 %0, %1, off" : "=v"(RA[i]) : "v"(Ag + (size_t)i * 32 * 64 + (size_t)(kt) * NTOK * 64)); \
    asm volatile("global_load_dwordx4 %0, %1, off" : "=v"(RB[i]) : "v"(Bg + (size_t)i * 32 * 64 + (size_t)(kt) * NBR * 64)); \
  }
#define LSTORE(RA, RB, s)                                                                  \
  _Pragma("unroll") for (int i = 0; i < 4; ++i) {                                          \
    *(u32x4*)(smem + (s) * 32768 + (crow + i * 32) * 128 + ((c16 ^ (((crow + i * 32) >> 1) & 7)) << 4)) = RA[i];          \
    *(u32x4*)(smem + (s) * 32768 + 16384 + (crow + i * 32) * 128 + ((c16 ^ (((crow + i * 32) >> 1) & 7)) << 4)) = RB[i];  \
  }
#define COMPUTE(s)                                                                                                   \
  {                                                                                                                  \
    const char* sA = smem + (s) * 32768;                                                                             \
    const char* sB = sA + 16384;                                                                                     \
    bf16x8 af0[4], bf0[4], af1[4], bf1[4];                                                                           \
    _Pragma("unroll") for (int m = 0; m < 4; ++m)                                                                    \
      af0[m] = *(const bf16x8*)(sA + (wr * 64 + m * 16 + fr) * 128 + (((0 + fq) ^ ((fr >> 1) & 7)) << 4));           \
    _Pragma("unroll") for (int n = 0; n < 4; ++n)                                                                    \
      bf0[n] = *(const bf16x8*)(sB + (wc * 64 + n * 16 + fr) * 128 + (((0 + fq) ^ ((fr >> 1) & 7)) << 4));           \
    _Pragma("unroll") for (int m = 0; m < 4; ++m)                                                                    \
      af1[m] = *(const bf16x8*)(sA + (wr * 64 + m * 16 + fr) * 128 + (((4 + fq) ^ ((fr >> 1) & 7)) << 4));           \
    _Pragma("unroll") for (int n = 0; n < 4; ++n)                                                                    \
      bf1[n] = *(const bf16x8*)(sB + (wc * 64 + n * 16 + fr) * 128 + (((4 + fq) ^ ((fr >> 1) & 7)) << 4));           \
    __builtin_amdgcn_sched_barrier(0);                                                                               \
    __builtin_amdgcn_s_setprio(1);                                                                                   \
    _Pragma("unroll") for (int m = 0; m < 4; ++m)                                                                    \
      _Pragma("unroll") for (int n = 0; n < 4; ++n)                                                                  \
        acc[m][n] = __builtin_amdgcn_mfma_f32_16x16x32_bf16(bf0[n], af0[m], acc[m][n], 0, 0, 0);                     \
    _Pragma("unroll") for (int m = 0; m < 4; ++m)                                                                    \
      _Pragma("unroll") for (int n = 0; n < 4; ++n)                                                                  \
        acc[m][n] = __builtin_amdgcn_mfma_f32_16x16x32_bf16(bf1[n], af1[m], acc[m][n], 0, 0, 0);                     \
    __builtin_amdgcn_s_setprio(0);                                                                                   \
  }
  GLOAD(ra0, rb0, 0);
  asm volatile("s_waitcnt vmcnt(0)" ::: "memory");
  LSTORE(ra0, rb0, 0);
  GLOAD(ra0, rb0, 1);
  __syncthreads();
  for (int kt = 0; kt < 16; kt += 2) {
    if (kt + 2 < 16) { GLOAD(ra1, rb1, kt + 2); }
    __builtin_amdgcn_sched_barrier(0);
    COMPUTE(0);
    __builtin_amdgcn_sched_barrier(0);
    if (kt + 2 < 16) asm volatile("s_waitcnt vmcnt(8)" ::: "memory");
    else asm volatile("s_waitcnt vmcnt(0)" ::: "memory");
    LSTORE(ra0, rb0, 1);
    __syncthreads();
    if (kt + 3 < 16) { GLOAD(ra0, rb0, kt + 3); }
    __builtin_amdgcn_sched_barrier(0);
    COMPUTE(1);
    __builtin_amdgcn_sched_barrier(0);
    if (kt + 2 < 16) {
      if (kt + 3 < 16) asm volatile("s_waitcnt vmcnt(8)" ::: "memory");
      else asm volatile("s_waitcnt vmcnt(0)" ::: "memory");
      LSTORE(ra1, rb1, 0);
    }
    __syncthreads();
  }
#undef COMPUTE
#undef GLOAD
#undef LSTORE
#pragma unroll
  for (int m = 0; m < 4; ++m) {
    int row = row0 + wr * 64 + m * 16 + fr;
#pragma unroll
    for (int n = 0; n < 4; ++n) {
      int col = col0 + wc * 64 + n * 16 + fq * 4;
      if (MODE == 0) {
        uint2 o;
        o.x = pk2(acc[m][n][0], acc[m][n][1]); o.y = pk2(acc[m][n][2], acc[m][n][3]);
        *(uint2*)(smem + (row - row0) * 272 + (col - col0) * 2) = o;
      } else {
        const float* hsrc;
        float* dst;
        int r;
        if (row < NLAT) {
          hsrc = (l == 0 ? P.x : P.out) + (size_t)row * 1024 + col;
          dst = P.out + (size_t)row * 1024 + col;
          r = row >> 11;
        } else {
          hsrc = P.ctx + (size_t)(row - NLAT) * 1024 + col;
          dst = P.hprectx + (size_t)(row - NLAT) * 1024 + col;
          r = 16;
        }
        float4 hv = *(const float4*)hsrc;
        float4 gt = *(const float4*)(P.mod + ((size_t)l * 17 + r) * 3072 + 2048 + col);
        float4 o;
        o.x = ALPHA_F * hv.x + gt.x * acc[m][n][0];
        o.y = ALPHA_F * hv.y + gt.y * acc[m][n][1];
        o.z = ALPHA_F * hv.z + gt.z * acc[m][n][2];
        o.w = ALPHA_F * hv.w + gt.w * acc[m][n][3];
        *(float4*)dst = o;
      }
    }
  }
  if (MODE == 0) {
    __syncthreads();
#pragma unroll
    for (int i = 0; i < 8; ++i) {
      const int c = tid + 256 * i, rr = c >> 4, cc = c & 15;
      u32x4 v = *(const u32x4*)(smem + rr * 272 + cc * 16);
      *(u32x4*)(P.p + PT(row0 + rr, col0) + cc * 8) = v;
    }
    __syncthreads();
  }
}

typedef __bf16 bf2_t __attribute__((ext_vector_type(2)));
typedef float fl2_t __attribute__((ext_vector_type(2)));
using bf16x4 = __attribute__((ext_vector_type(4))) short;
__device__ __forceinline__ bf16_t f2bfh(float a) { return (bf16_t)(pk2(a, 0.f) & 0xffffu); }
__device__ __forceinline__ float rlane(float x, int l) {
  return __builtin_bit_cast(float, __builtin_amdgcn_readlane(__builtin_bit_cast(int, x), l));
}
__device__ __forceinline__ void wave_sync() {
  asm volatile("s_waitcnt lgkmcnt(0)" ::: "memory");
  __builtin_amdgcn_wave_barrier();
}
union U8 { bf16x8 v; unsigned u[4]; uint4 q; };
union U4 { bf16x4 v; unsigned u[2]; uint2 q; };
__device__ __forceinline__ bf16x8 pack8(f32x4 a, f32x4 b) {
  U8 r;
  r.u[0] = pk2(a[0], a[1]); r.u[1] = pk2(a[2], a[3]); r.u[2] = pk2(b[0], b[1]); r.u[3] = pk2(b[2], b[3]);
  return r.v;
}
__device__ __forceinline__ f32x4 unpack4(uint2 w) {
  f32x4 r;
  r[0] = __uint_as_float(w.x << 16); r[1] = __uint_as_float(w.x & 0xffff0000u);
  r[2] = __uint_as_float(w.y << 16); r[3] = __uint_as_float(w.y & 0xffff0000u);
  return r;
}
#define RSLOT 14592
using u32x2 = __attribute__((ext_vector_type(2))) unsigned;
#define GLD(T, p) (*(const __attribute__((address_space(1))) T*)(p))
#define GST(T, p, v) (*(__attribute__((address_space(1))) T*)(p) = (v))
#define MFMA32(a, b, c) __builtin_amdgcn_mfma_f32_16x16x32_bf16(a, b, c, 0, 0, 0)
#define MFMA16(a, b, c) __builtin_amdgcn_mfma_f32_16x16x16bf16_1k(a, b, c, 0, 0, 0)

__device__ void rwkv_unit2(const Params& P, int l, int b, int h, int d, char* smem, int unit) {
  const int tid = opq(threadIdx.x), lane0 = tid & 63, wave = __builtin_amdgcn_readfirstlane(tid >> 6);
  char* wsm = smem + wave * 16384;
  bf16_t* Q1 = (bf16_t*)wsm;
  bf16_t* Q2 = (bf16_t*)(wsm + 2048);
  bf16_t* Q3 = (bf16_t*)(wsm + 4096);
  bf16_t* Q4 = (bf16_t*)(wsm + 6144);
  float* F = (float*)(wsm + 8192);
  char* ring0 = P.ring + (size_t)unit * 4 * RSLOT;
  const bf16_t* WT = P.loraT + (size_t)((l * 2 + d) * 6 + h) * 4096;
  const bf16_t* AT = WT + (size_t)24 * 4096;
  const float w0j = P.rwkv_w0[(l * 2 + d) * 384 + h * 64 + lane0];
  const float a0j = P.rwkv_a0[(l * 2 + d) * 384 + h * 64 + lane0];
  const float kkj = P.rwkv_k_k[l * 384 + h * 64 + lane0];
  const float kaj = P.rwkv_k_a[l * 384 + h * 64 + lane0];
  const float rkj = P.rwkv_r_k[((l * 2 + d) * 6 + h) * 64 + lane0];
  f32x4 accS[4];
#pragma unroll
  for (int mt = 0; mt < 4; ++mt) accS[mt] = f32x4{0.f, 0.f, 0.f, 0.f};

  unsigned pfd[2] = {0u, 0u};
  for (int rnd = 0; rnd < 36; ++rnd) {
    int L, base;
    if (rnd < 4) { L = CTXL; base = NLAT + b * CTXL; }
    else { L = SEQL; base = b * SEQL; }
    const int rr0 = (rnd < 4) ? rnd : rnd - 4;
    const int lane = opq(lane0), fr = lane & 15, q = lane >> 4, j = lane;
    const int offA = (j >> 5) * 1024 + ((j >> 2) & 3) * 256 + ((j >> 4) & 1) * 8 + (j & 3) * 2;
    char* ring = ring0;
    asm volatile("" : "+s"(ring));
    char* myslot = ring + wave * RSLOT;
    {
      const int spos = (rr0 * 4 + wave) * 16;
      const int t0 = d ? (L - 1 - spos) : spos;
      const int tlo = d ? (t0 - 15) : t0;
      float rv[16], kv[16], vv[16];
      {
        __amdgpu_buffer_rsrc_t prs = __builtin_amdgcn_make_buffer_rsrc((void*)P.p, 0, 0x7ffffff0, 0x00020000);
        int uc_[5];
        uc_[0] = 1152 + d * 64; uc_[1] = 1280 + d * 64; uc_[2] = h * 64; uc_[3] = 384 + h * 64; uc_[4] = 768 + h * 64;
        const bool vprev = d ? (t0 < L - 1) : (t0 > 0);
        const bool vnext = d ? (t0 - 15 > 0) : (t0 + 15 < L - 1);
        const int tmin = d ? (t0 - 16) : (t0 - 1);
        char* stg = wsm + 4096;
        const int lrow = opq(lane) >> 3, lc8 = lane & 7;
        u32x4 pcs[5][3];
#pragma unroll
        for (int g = 0; g < 5; ++g) {
          const int so = __builtin_amdgcn_readfirstlane((PTOFF(256 + uc_[g]) + (base + tmin) * 128) * 2);
#pragma unroll
          for (int k = 0; k < 3; ++k) {
            const int rr = lrow + 8 * k;
            const int ridx = d ? (17 - rr) : rr;
            pcs[g][k] = u32x4{0u, 0u, 0u, 0u};
            const bool ok = (rr < 18) && !((rr == 0) && !vprev) && !((rr == 17) && !vnext);
            if (ok) pcs[g][k] = __builtin_amdgcn_raw_buffer_load_b128(prs, ridx * 256 + lc8 * 16, so, 0);
          }
        }
#pragma unroll
        for (int g = 0; g < 5; ++g)
#pragma unroll
          for (int k = 0; k < 3; ++k) {
            const int rr = lrow + 8 * k;
            if (rr < 18) *(u32x4*)(stg + (g * 18 + rr) * 128 + lc8 * 16) = pcs[g][k];
          }
        wave_sync();
        bf16_t raw[5][18];
#pragma unroll
        for (int g = 0; g < 5; ++g)
#pragma unroll
          for (int rr = 0; rr < 18; ++rr) raw[g][rr] = *(const bf16_t*)(stg + (g * 18 + rr) * 128 + j * 2);
        wave_sync();
        __builtin_amdgcn_sched_barrier(0);
#pragma unroll
        for (int g = 0; g < 5; ++g) {
          const int uc = uc_[g] + j;
          const float ca = P.rwkv_shift[(l * 3 + 0) * 1408 + uc], c1 = P.rwkv_shift[(l * 3 + 1) * 1408 + uc],
                      cb = P.rwkv_shift[(l * 3 + 2) * 1408 + uc];
          const float cprev = d ? cb : ca, cnext = d ? ca : cb;
#pragma unroll
          for (int i = 0; i < 16; ++i) {
            float val = cprev * bf2f(raw[g][i]) + c1 * bf2f(raw[g][i + 1]) + cnext * bf2f(raw[g][i + 2]);
            if (g == 0) Q1[i * 64 + j] = f2bfh(ftanh(val));
            else if (g == 1) Q2[i * 64 + j] = f2bfh(val);
            else if (g == 2) rv[i] = val;
            else if (g == 3) kv[i] = val;
            else vv[i] = val;
          }
        }
      }
      wave_sync();
      float* G = F + 1024;
#pragma unroll
      for (int nt = 0; nt < 4; ++nt) {
        f32x4 acc = {0.f, 0.f, 0.f, 0.f}, acc2 = acc;
#pragma unroll
        for (int s = 0; s < 2; ++s) {
          bf16x8 a = *(const bf16x8*)(Q1 + fr * 64 + s * 32 + q * 8);
          bf16x8 bw = *(const bf16x8*)(WT + (16 * nt + fr) * 64 + s * 32 + q * 8);
          acc = MFMA32(a, bw, acc);
          bf16x8 a2 = *(const bf16x8*)(Q2 + fr * 64 + s * 32 + q * 8);
          bf16x8 bw2 = *(const bf16x8*)(AT + (16 * nt + fr) * 64 + s * 32 + q * 8);
          acc2 = MFMA32(a2, bw2, acc2);
        }
#pragma unroll
        for (int jj = 0; jj < 4; ++jj) {
          F[(4 * q + jj) * 64 + 16 * nt + fr] = acc[jj];
          G[(4 * q + jj) * 64 + 16 * nt + fr] = acc2[jj];
        }
      }
      wave_sync();
      float kt[16];
      float khv[16], bhv[16];
      {
        float av[16], ssv[16];
        {
          float* R1 = (float*)Q1;
          float* R2 = (float*)Q3;
          float sq[16], bt[16];
#pragma unroll
          for (int i = 0; i < 16; ++i) {
            float a = sigmf(G[i * 64 + j] + a0j);
            av[i] = a;
            float kkv = kv[i] * kkj;
            sq[i] = kkv * kkv;
            bt[i] = rv[i] * (kv[i] * (1.f + (a - 1.f) * kaj)) * rkj;
          }
#pragma unroll
          for (int c4 = 0; c4 < 4; ++c4) {
            *(f32x4*)(R2 + j * 16 + c4 * 4) = f32x4{sq[c4 * 4], sq[c4 * 4 + 1], sq[c4 * 4 + 2], sq[c4 * 4 + 3]};
            *(f32x4*)(R1 + j * 16 + c4 * 4) = f32x4{bt[c4 * 4], bt[c4 * 4 + 1], bt[c4 * 4 + 2], bt[c4 * 4 + 3]};
          }
          wave_sync();
          float s1 = 0.f, s2 = 0.f;
#pragma unroll
          for (int k = 0; k < 16; ++k) {
            s1 += R2[(q * 16 + k) * 16 + fr];
            s2 += R1[(q * 16 + k) * 16 + fr];
          }
          s1 += __shfl_xor(s1, 16); s1 += __shfl_xor(s1, 32);
          s2 += __shfl_xor(s2, 16); s2 += __shfl_xor(s2, 32);
          if (lane < 16) {
            G[lane] = s1;
            const int tb = d ? (t0 - lane) : (t0 + lane);
            P.bonus[(size_t)(base + tb) * 12 + d * 6 + h] = s2;
          }
          wave_sync();
#pragma unroll
          for (int c4 = 0; c4 < 4; ++c4) {
            f32x4 x = *(const f32x4*)(G + c4 * 4);
            ssv[c4 * 4] = x[0]; ssv[c4 * 4 + 1] = x[1]; ssv[c4 * 4 + 2] = x[2]; ssv[c4 * 4 + 3] = x[3];
          }
          wave_sync();
        }
        float g = 0.f, eg = 1.f;
#pragma unroll
        for (int i = 0; i < 16; ++i) {
          float wl = F[i * 64 + j] + w0j;
          float lw = -0.60653066f * frcp(1.f + __expf(-wl));
          const float egp = eg;
          g += lw;
          float a = av[i];
          float kkv = kv[i] * kkj;
          float kk = kkv * __builtin_amdgcn_rsqf(ssv[i] + 1e-12f);
          float kmod = kv[i] * (1.f + (a - 1.f) * kaj);
          float bb = a * kk;
          eg = __expf(g);
          float eng = frcp(eg);
          kt[i] = kk * egp;
          khv[i] = kmod * eng;
          bhv[i] = bb * eng;
          Q1[i * 64 + j] = f2bfh(kt[i]);
          Q2[i * 64 + j] = f2bfh(rv[i] * eg);
          Q3[i * 64 + j] = f2bfh(bhv[i]);
          Q4[i * 64 + j] = f2bfh(khv[i]);
        }
        const float pC = eg;
        GST(float, myslot + 14336 + j * 4, pC);
#pragma unroll
        for (int qq = 0; qq < 4; ++qq) {
          uint4 o;
          o.x = pk2(khv[4 * qq] * pC, khv[4 * qq + 1] * pC);
          o.y = pk2(khv[4 * qq + 2] * pC, khv[4 * qq + 3] * pC);
          o.z = pk2(-bhv[4 * qq] * pC, -bhv[4 * qq + 1] * pC);
          o.w = pk2(-bhv[4 * qq + 2] * pC, -bhv[4 * qq + 3] * pC);
          GST(u32x4, myslot + 4096 + ((q * 64 + qq * 16 + fr) * 16), (u32x4{o.x, o.y, o.z, o.w}));
          uint2 ov;
          ov.x = pk2(vv[4 * qq], vv[4 * qq + 1]);
          ov.y = pk2(vv[4 * qq + 2], vv[4 * qq + 3]);
          GST(u32x2, myslot + 8192 + ((q * 64 + qq * 16 + fr) * 8), (u32x2{ov.x, ov.y}));
        }
        {
          uint4 o0, o1;
          o0.x = pk2(kt[0], kt[1]); o0.y = pk2(kt[2], kt[3]); o0.z = pk2(kt[4], kt[5]); o0.w = pk2(kt[6], kt[7]);
          o1.x = pk2(kt[8], kt[9]); o1.y = pk2(kt[10], kt[11]); o1.z = pk2(kt[12], kt[13]); o1.w = pk2(kt[14], kt[15]);
          *(uint4*)((char*)G + j * 32) = o0;
          *(uint4*)((char*)G + j * 32 + 16) = o1;
          o0.x = pk2(vv[0], vv[1]); o0.y = pk2(vv[2], vv[3]); o0.z = pk2(vv[4], vv[5]); o0.w = pk2(vv[6], vv[7]);
          o1.x = pk2(vv[8], vv[9]); o1.y = pk2(vv[10], vv[11]); o1.z = pk2(vv[12], vv[13]); o1.w = pk2(vv[14], vv[15]);
          *(uint4*)((char*)G + 2048 + j * 32) = o0;
          *(uint4*)((char*)G + 2048 + j * 32 + 16) = o1;
        }
      }
      wave_sync();
      f32x4 aM = {0.f, 0.f, 0.f, 0.f}, aN = aM, aRb = aM, aRk = aM;
#pragma unroll
      for (int s = 0; s < 2; ++s) {
        bf16x8 x1 = *(const bf16x8*)(Q1 + fr * 64 + s * 32 + q * 8);
        bf16x8 x2 = *(const bf16x8*)(Q2 + fr * 64 + s * 32 + q * 8);
        bf16x8 x3 = *(const bf16x8*)(Q3 + fr * 64 + s * 32 + q * 8);
        bf16x8 x4 = *(const bf16x8*)(Q4 + fr * 64 + s * 32 + q * 8);
        aM = MFMA32(x3, x1, aM);
        aN = MFMA32(x4, x1, aN);
        aRb = MFMA32(x3, x2, aRb);
        aRk = MFMA32(x4, x2, aRk);
      }
#pragma unroll
      for (int jj = 0; jj < 4; ++jj) {
        const int ii = 4 * q + jj;
        if (!(ii < fr)) { aM[jj] = 0.f; aN[jj] = 0.f; }
        if (!(ii <= fr)) { aRb[jj] = 0.f; aRk[jj] = 0.f; }
      }
      {
        const int c = lane & 15;
        float tt[16];
#pragma unroll
        for (int t = 0; t < 16; ++t) {
          float acc = (t == c) ? 1.f : 0.f;
#pragma unroll
          for (int i = 0; i < t; ++i) acc -= rlane(aM[i & 3], (i >> 2) * 16 + t) * tt[i];
          tt[t] = acc;
        }
        if (lane < 16) {
#pragma unroll
          for (int t = 0; t < 16; ++t) F[t * 16 + c] = tt[t];
        }
      }
      wave_sync();
      {
        U4 tA, nA, rbA, rkA;
        f32x4 tv = *(const f32x4*)(F + fr * 16 + 4 * q);
        tA.u[0] = pk2(tv[0], tv[1]); tA.u[1] = pk2(tv[2], tv[3]);
        nA.u[0] = pk2(aN[0], aN[1]); nA.u[1] = pk2(aN[2], aN[3]);
        rbA.u[0] = pk2(-aRb[0], -aRb[1]); rbA.u[1] = pk2(-aRb[2], -aRb[3]);
        rkA.u[0] = pk2(aRk[0], aRk[1]); rkA.u[1] = pk2(aRk[2], aRk[3]);
        const f32x4 z4 = {0.f, 0.f, 0.f, 0.f};
#pragma unroll
        for (int nt = 0; nt < 4; ++nt) {
          U4 kB, vB;
          kB.q = *(const uint2*)((const char*)G + (16 * nt + fr) * 32 + 8 * q);
          vB.q = *(const uint2*)((const char*)G + 2048 + (16 * nt + fr) * 32 + 8 * q);
          f32x4 kbar = MFMA16(tA.v, kB.v, z4);
          U4 kbB; kbB.u[0] = pk2(kbar[0], kbar[1]); kbB.u[1] = pk2(kbar[2], kbar[3]);
          f32x4 rtd;
#pragma unroll
          for (int jj = 0; jj < 4; ++jj) rtd[jj] = bf2f(Q2[(4 * q + jj) * 64 + 16 * nt + fr]);
          f32x4 rp = MFMA16(rbA.v, kbB.v, rtd);
          f32x4 nv = MFMA16(nA.v, vB.v, z4);
          U4 nvB; nvB.u[0] = pk2(nv[0], nv[1]); nvB.u[1] = pk2(nv[2], nv[3]);
          f32x4 w2 = MFMA16(tA.v, nvB.v, z4);
          U4 w2B; w2B.u[0] = pk2(w2[0], w2[1]); w2B.u[1] = pk2(w2[2], w2[3]);
          f32x4 yi = MFMA16(rkA.v, vB.v, z4);
          yi = MFMA16(rbA.v, w2B.v, yi);
          const int chan = 16 * nt + fr;
          const int oA = (chan >> 5) * 1024 + ((chan >> 2) & 3) * 256 + ((chan >> 4) & 1) * 8 + (chan & 3) * 2;
#pragma unroll
          for (int jj = 0; jj < 4; ++jj) {
            GST(bf16_t, myslot + oA + (4 * q + jj) * 16, f2bfh(kbar[jj]));
            GST(bf16_t, myslot + 2048 + oA + (4 * q + jj) * 16, f2bfh(rp[jj]));
          }
          GST(u32x2, myslot + 10240 + ((nt * 64 + lane) * 8), (u32x2{w2B.u[0], w2B.u[1]}));
          uint2 yo; yo.x = pk2(yi[0], yi[1]); yo.y = pk2(yi[2], yi[3]);
          GST(u32x2, myslot + 12288 + ((nt * 64 + lane) * 8), (u32x2{yo.x, yo.y}));
        }
      }
    }
    __syncthreads();
    asm volatile("" ::"v"(pfd[0]), "v"(pfd[1]));
    {
      {
        int nr = rnd + 1;
        if (nr < 36) {
          int Ln, basen;
          if (nr < 4) { Ln = CTXL; basen = NLAT + b * CTXL; }
          else { Ln = SEQL; basen = b * SEQL; }
          const int rrn = (nr < 4) ? nr : nr - 4;
          const int sposn = (rrn * 4 + wave) * 16;
          const int t0n = d ? (Ln - 1 - sposn) : sposn;
          const int tlon = d ? (t0n - 15) : t0n;
#pragma unroll
          for (int hlf = 0; hlf < 2; ++hlf) {
            int idx = lane + hlf * 64;
            if (idx < 90) {
              int ga = idx / 18, rr = idx % 18;
              int trow = tlon - 1 + rr;
              int col = (ga == 0) ? (h * 64) : (ga == 1) ? (384 + h * 64) : (ga == 2) ? (768 + h * 64) : (ga == 3) ? (1152 + d * 64) : (1280 + d * 64);
              if (trow >= 0 && trow < Ln) {
                asm volatile("global_load_ubyte %0, %1, off" : "=v"(pfd[hlf]) : "v"(P.p + PT(basen + trow, 256 + col)));
              }
            }
          }
        }
      }
      struct SeqOps { bf16x8 ka0, ka1, ra0, ra1, kb[4]; f32x4 pc[4]; u32x2 vq, w2q, yiq; };
      SeqOps cur, nxt;
#define LOADOPS(O, sc_)                                                          \
  {                                                                               \
    const char* sl = ring + (sc_) * RSLOT;                                        \
    O.ka0 = GLD(bf16x8, sl + lane * 16);                                     \
    O.ka1 = GLD(bf16x8, sl + 1024 + lane * 16);                              \
    O.ra0 = GLD(bf16x8, sl + 2048 + lane * 16);                              \
    O.ra1 = GLD(bf16x8, sl + 3072 + lane * 16);                              \
    _Pragma("unroll") for (int mt = 0; mt < 4; ++mt) {                            \
      O.kb[mt] = GLD(bf16x8, sl + 4096 + (mt * 64 + lane) * 16);             \
      O.pc[mt] = GLD(f32x4, sl + 14336 + (16 * mt + 4 * q) * 4);             \
    }                                                                             \
    O.vq = GLD(u32x2, sl + 8192 + (wave * 64 + lane) * 8);                   \
    O.w2q = GLD(u32x2, sl + 10240 + (wave * 64 + lane) * 8);                 \
    O.yiq = GLD(u32x2, sl + 12288 + (wave * 64 + lane) * 8);                 \
  }
      LOADOPS(cur, 0);
#pragma unroll
      for (int sc = 0; sc < 4; ++sc) {
        if (sc < 3) LOADOPS(nxt, sc + 1);
        bf16x8 B0 = pack8(accS[0], accS[1]);
        bf16x8 B1 = pack8(accS[2], accS[3]);
        f32x4 accU = unpack4(make_uint2(cur.w2q.x, cur.w2q.y));
        accU = MFMA32(cur.ka0, B0, accU);
        accU = MFMA32(cur.ka1, B1, accU);
        f32x4 accY = unpack4(make_uint2(cur.yiq.x, cur.yiq.y));
        accY = MFMA32(cur.ra0, B0, accY);
        accY = MFMA32(cur.ra1, B1, accY);
        U8 z;
        z.u[0] = cur.vq.x; z.u[1] = cur.vq.y;
        z.u[2] = pk2(accU[0], accU[1]); z.u[3] = pk2(accU[2], accU[3]);
#pragma unroll
        for (int mt = 0; mt < 4; ++mt) {
          f32x4 c = accS[mt] * cur.pc[mt];
          accS[mt] = MFMA32(cur.kb[mt], z.v, c);
        }
        const int spos = (rr0 * 4 + sc) * 16;
#pragma unroll
        for (int jj = 0; jj < 4; ++jj) {
          int s = spos + 4 * q + jj;
          int t = d ? (L - 1 - s) : s;
          P.yrec[(size_t)(base + t) * YREC + d * 384 + h * 64 + 16 * wave + fr] = f2bfh(accY[jj]);
        }
        if (sc < 3) cur = nxt;
      }
#undef LOADOPS
    }
    asm volatile("s_waitcnt lgkmcnt(0)\n\ts_barrier" ::: "memory");
  }
  asm volatile("s_waitcnt vmcnt(0)" ::: "memory");
  asm volatile("" ::"v"(pfd[0]), "v"(pfd[1]));
}

#define HSLOT 8448
__device__ void hgrn_unit2(const Params& P, int l, int b, int h, int d, char* smem) {
  const int tid = opq(threadIdx.x), lane0 = tid & 63, wave = __builtin_amdgcn_readfirstlane(tid >> 6);
  char* slots = smem;
  char* wsm = smem + 4 * HSLOT + wave * 6144;
  bf16_t* Q1 = (bf16_t*)wsm;
  bf16_t* Q2 = (bf16_t*)(wsm + 2048);
  float* F = (float*)(wsm + 4096);
  char* myslot = slots + wave * HSLOT;
  float lb;
  {
    float x0 = P.hgrn_lb[(d * 2 + 0) * 384 + h * 64 + lane0];
    float x1 = P.hgrn_lb[(d * 2 + 1) * 384 + h * 64 + lane0];
    float mx = fmaxf(x0, x1);
    float e0 = expf(x0 - mx), e1 = expf(x1 - mx);
    float w0 = e0 / (e0 + e1), w1 = e1 / (e0 + e1);
    lb = (l == 0) ? 0.f : fmaxf((w0 + w1) - w0, 0.f);
  }
  f32x4 accS[4];
#pragma unroll
  for (int mt = 0; mt < 4; ++mt) accS[mt] = f32x4{0.f, 0.f, 0.f, 0.f};
  for (int rnd = 0; rnd < 36; ++rnd) {
    int L, base;
    if (rnd < 4) { L = CTXL; base = NLAT + b * CTXL; }
    else { L = SEQL; base = b * SEQL; }
    const int rr0 = (rnd < 4) ? rnd : rnd - 4;
    const int lane = opq(lane0), fr = lane & 15, q = lane >> 4, j = lane;
    const int offA = (j >> 5) * 1024 + ((j >> 2) & 3) * 256 + ((j >> 4) & 1) * 8 + (j & 3) * 2;
    {
      const int spos = (rr0 * 4 + wave) * 16;
      float iv[16], gg[16], kh[16];
      float g = 0.f;
      const int t0 = d ? (L - 1 - spos) : spos;
      const int tlo = d ? (t0 - 15) : t0;
      bf16_t qr[16], ir[16], zr[16];
      {
        __amdgpu_buffer_rsrc_t prs = __builtin_amdgcn_make_buffer_rsrc((void*)P.p, 0, 0x7ffffff0, 0x00020000);
        const int lrow = opq(lane) >> 3, lc8 = lane & 7;
        u32x4 pcs[3][2];
#pragma unroll
        for (int g2 = 0; g2 < 3; ++g2) {
          const int colg = (g2 == 0) ? (1664 + h * 64) : ((g2 == 1) ? (2048 + h * 64) : (2432 + d * 384 + h * 64));
          const int so = __builtin_amdgcn_readfirstlane((PTOFF(colg) + (base + tlo) * 128) * 2);
#pragma unroll
          for (int k = 0; k < 2; ++k) pcs[g2][k] = __builtin_amdgcn_raw_buffer_load_b128(prs, (lrow + 8 * k) * 256 + lc8 * 16, so, 0);
        }
#pragma unroll
        for (int g2 = 0; g2 < 3; ++g2)
#pragma unroll
          for (int k = 0; k < 2; ++k) *(u32x4*)(wsm + (g2 * 16 + lrow + 8 * k) * 128 + lc8 * 16) = pcs[g2][k];
        wave_sync();
#pragma unroll
        for (int i = 0; i < 16; ++i) {
          const int r = d ? (15 - i) : i;
          qr[i] = *(const bf16_t*)(wsm + (0 * 16 + r) * 128 + j * 2);
          ir[i] = *(const bf16_t*)(wsm + (1 * 16 + r) * 128 + j * 2);
          zr[i] = *(const bf16_t*)(wsm + (2 * 16 + r) * 128 + j * 2);
        }
        wave_sync();
      }
#pragma unroll
      for (int i = 0; i < 16; ++i) {
        float qv = bf2f(qr[i]);
        iv[i] = bf2f(ir[i]);
        float z = bf2f(zr[i]);
        float sg = sigmf(z);
        float f = lb + (1.f - lb) * sg;
        float k = (1.f - lb) * (1.f - sg);
        g += __logf(f);
        gg[i] = g;
        kh[i] = k;
        float qt = qv * __expf(g);
        Q1[i * 64 + j] = f2bfh(qt);
        Q2[i * 64 + j] = f2bfh(k * __expf(-g));
        *(bf16_t*)(myslot + offA + i * 16) = f2bfh(qt);
      }
      const float gC = g;
      *(float*)(myslot + 8192 + j * 4) = __expf(gC);
#pragma unroll
      for (int qq = 0; qq < 4; ++qq) {
        uint2 o;
        o.x = pk2(kh[4 * qq] * __expf(gC - gg[4 * qq]), kh[4 * qq + 1] * __expf(gC - gg[4 * qq + 1]));
        o.y = pk2(kh[4 * qq + 2] * __expf(gC - gg[4 * qq + 2]), kh[4 * qq + 3] * __expf(gC - gg[4 * qq + 3]));
        *(uint2*)(myslot + 2048 + ((q * 64 + qq * 16 + fr) * 8)) = o;
        o.x = pk2(iv[4 * qq], iv[4 * qq + 1]);
        o.y = pk2(iv[4 * qq + 2], iv[4 * qq + 3]);
        *(uint2*)(myslot + 4096 + ((q * 64 + qq * 16 + fr) * 8)) = o;
      }
      wave_sync();
      f32x4 aA = {0.f, 0.f, 0.f, 0.f};
#pragma unroll
      for (int s = 0; s < 2; ++s) {
        bf16x8 x1 = *(const bf16x8*)(Q1 + fr * 64 + s * 32 + q * 8);
        bf16x8 x2 = *(const bf16x8*)(Q2 + fr * 64 + s * 32 + q * 8);
        aA = MFMA32(x2, x1, aA);
      }
      wave_sync();
      float oi[16];
#pragma unroll
      for (int t = 0; t < 16; ++t) {
        float o = 0.f;
#pragma unroll
        for (int i = 0; i <= t; ++i) o += rlane(aA[i & 3], (i >> 2) * 16 + t) * iv[i];
        oi[t] = o;
      }
#pragma unroll
      for (int qq = 0; qq < 4; ++qq) {
        uint2 o;
        o.x = pk2(oi[4 * qq], oi[4 * qq + 1]);
        o.y = pk2(oi[4 * qq + 2], oi[4 * qq + 3]);
        *(uint2*)(myslot + 6144 + ((q * 64 + qq * 16 + fr) * 8)) = o;
      }
    }
    __syncthreads();
#pragma unroll 1
    for (int sc = 0; sc < 4; ++sc) {
      const char* sl = slots + sc * HSLOT;
      bf16x8 qa0 = *(const bf16x8*)(sl + lane * 16);
      bf16x8 qa1 = *(const bf16x8*)(sl + 1024 + lane * 16);
      U4 kc[4];
      f32x4 pc[4];
#pragma unroll
      for (int mt = 0; mt < 4; ++mt) {
        kc[mt].q = *(const uint2*)(sl + 2048 + (mt * 64 + lane) * 8);
        pc[mt] = *(const f32x4*)(sl + 8192 + (16 * mt + 4 * q) * 4);
      }
      U4 iq;
      iq.q = *(const uint2*)(sl + 4096 + (wave * 64 + lane) * 8);
      uint2 oiq = *(const uint2*)(sl + 6144 + (wave * 64 + lane) * 8);
      bf16x8 B0 = pack8(accS[0], accS[1]);
      bf16x8 B1 = pack8(accS[2], accS[3]);
      f32x4 accO = unpack4(oiq);
      accO = MFMA32(qa0, B0, accO);
      accO = MFMA32(qa1, B1, accO);
#pragma unroll
      for (int mt = 0; mt < 4; ++mt) {
        f32x4 c = accS[mt] * pc[mt];
        accS[mt] = MFMA16(kc[mt].v, iq.v, c);
      }
      const int spos = (rr0 * 4 + sc) * 16;
#pragma unroll
      for (int jj = 0; jj < 4; ++jj) {
        int s = spos + 4 * q + jj;
        int t = d ? (L - 1 - s) : s;
        P.yrec[(size_t)(base + t) * YREC + 768 + d * 384 + h * 64 + 16 * wave + fr] = f2bfh(accO[jj]);
      }
    }
    __syncthreads();
  }
}

__device__ void mix_tile(const Params& P, int l, int tile, float* sm, int part) {
  const int tid = opq(threadIdx.x), lane = tid & 63, wave = __builtin_amdgcn_readfirstlane(tid >> 6);
  int base, segbase, n, tloc0, L, seq0;
  if (tile < 512) { base = tile * 64; segbase = base; n = 64; tloc0 = 0; L = SEQL; seq0 = (tile >> 5) * SEQL; }
  else {
    int ct = tile - 512;
    int b = ct >> 2;
    tloc0 = (ct & 3) * 64;
    segbase = NLAT + b * CTXL;
    base = segbase + tloc0;
    n = CTXL; L = CTXL; seq0 = segbase;
  }
  float* spv = sm;
  float* spT = sm + 80 * 64;
  float* spw = spT + 64 * 68;
  if (part & 1)
  for (int g = 0; g < 4; ++g) {
    int win = 2 << g, left = win >> 1, right = win - 1 - left;
    {
      float vals[20];
#pragma unroll
      for (int k = 0; k < 20; ++k) {
        int e = tid + k * 256;
        int ii = e >> 6, cch = e & 63;
        int tt = tloc0 - 8 + ii;
        vals[k] = (tt >= 0 && tt < n) ? bf2f(P.p[PT(segbase + tt, g * 64 + cch)]) : 0.f;
      }
      f32x4 wv[4];
#pragma unroll
      for (int k = 0; k < 4; ++k) wv[k] = *(const f32x4*)(P.pool_w + (size_t)(l * 4 + g) * 4096 + (tid + k * 256) * 4);
#pragma unroll
      for (int k = 0; k < 20; ++k) spv[tid + k * 256] = vals[k];
#pragma unroll
      for (int k = 0; k < 4; ++k) *(f32x4*)(spw + (tid + k * 256) * 4) = wv[k];
    }
    __syncthreads();
    for (int e = tid; e < 4096; e += 256) {
      int i = e >> 6, cch = e & 63;
      int t = tloc0 + i;
      int lo = max(t - left, 0), hi = min(t + right, n - 1) + 1;
      float s = 0.f;
      for (int tt = lo; tt < hi; ++tt) s += spv[(tt - tloc0 + 8) * 64 + cch];
      spT[cch * 68 + i] = s * frcp((float)(hi - lo)) - spv[(i + 8) * 64 + cch];
    }
    __syncthreads();
    const int col = g * 64 + lane;
    float gatev[16];
#pragma unroll
    for (int r = 0; r < 16; ++r) gatev[r] = bf2f(P.p[PT(base + wave * 16 + r, 3200 + col)]);
    float acc[16];
#pragma unroll
    for (int r = 0; r < 16; ++r) acc[r] = 0.f;
#pragma unroll 4
    for (int cch = 0; cch < 64; ++cch) {
      float w = spw[cch * 64 + lane];
      const f32x4* tp = (const f32x4*)(spT + cch * 68 + wave * 16);
      f32x4 t0 = tp[0], t1 = tp[1], t2 = tp[2], t3 = tp[3];
#pragma unroll
      for (int e = 0; e < 4; ++e) {
        acc[e] += t0[e] * w; acc[4 + e] += t1[e] * w; acc[8 + e] += t2[e] * w; acc[12 + e] += t3[e] * w;
      }
    }
    float psc = P.pool_scale[l * 256 + col];
#pragma unroll
    for (int r = 0; r < 16; ++r) {
      int token = base + wave * 16 + r;
      P.xn[XT(token, col)] = f2bf(acc[r] * psc * siluf(gatev[r]));
    }
    __syncthreads();
  }
  if (part & 2) {
    const int grp = lane >> 4, c4 = (lane & 15) * 4;
#pragma unroll 1
    for (int pass = 0; pass < 3; ++pass) {
      const int hh = pass * 4 + grp;
      const bool isr = hh < 6;
      const int ch = (isr ? hh : hh - 6) * 64 + c4;
      const int uc = 768 + ch;
      const int oya = isr ? ch : 768 + ch, oyb = isr ? 384 + ch : 1152 + ch;
      const int ogate = 3200 + (isr ? 256 : 640) + ch, omix = (isr ? 256 : 640) + ch;
      f32x4 s0 = {0.f, 0.f, 0.f, 0.f}, s1 = s0, s2 = s0, gg = s0, gb = s0;
      if (isr) {
        s0 = *(const f32x4*)(P.rwkv_shift + (l * 3 + 0) * 1408 + uc);
        s1 = *(const f32x4*)(P.rwkv_shift + (l * 3 + 1) * 1408 + uc);
        s2 = *(const f32x4*)(P.rwkv_shift + (l * 3 + 2) * 1408 + uc);
        gg = *(const f32x4*)(P.rwkv_gn_g + l * 384 + ch);
        gb = *(const f32x4*)(P.rwkv_gn_b + l * 384 + ch);
      } else {
        gg = *(const f32x4*)(P.hgrn_norm_g + l * 384 + ch);
      }
#pragma unroll 1
      for (int r0 = 0; r0 < 16; r0 += 4) {
        uint2 ya[4], yb[4], vm[4], vl[4], vh[4], gt[4];
        float bon[4];
#pragma unroll
        for (int u = 0; u < 4; ++u) {
          const int token = base + wave * 16 + r0 + u;
          const int t = token - seq0;
          const bf16_t* yr = P.yrec + (size_t)token * YREC;
          ya[u] = *(const uint2*)(yr + oya);
          yb[u] = *(const uint2*)(yr + oyb);
          gt[u] = *(const uint2*)(P.p + PT(token, ogate));
          vm[u] = make_uint2(0u, 0u); vl[u] = vm[u]; vh[u] = vm[u]; bon[u] = 0.f;
          if (isr) {
            bon[u] = P.bonus[(size_t)token * 12 + hh] + P.bonus[(size_t)token * 12 + 6 + hh];
            const bf16_t* pv = P.p + PT(token, 256 + uc);
            vm[u] = *(const uint2*)pv;
            if (t > 0) vl[u] = *(const uint2*)(pv - 128);
            if (t < L - 1) vh[u] = *(const uint2*)(pv + 128);
          }
        }
#pragma unroll
        for (int u = 0; u < 4; ++u) {
          const int token = base + wave * 16 + r0 + u;
          f32x4 y = unpack4(ya[u]) + unpack4(yb[u]);
          f32x4 gate = unpack4(gt[u]);
          f32x4 o;
          if (isr) {
            float mu = rsum16(y[0] + y[1] + y[2] + y[3]) * (1.f / 64.f);
            f32x4 dl = y - mu;
            float var = rsum16(dl[0] * dl[0] + dl[1] * dl[1] + dl[2] * dl[2] + dl[3] * dl[3]) * (1.f / 64.f);
            float rs = __builtin_amdgcn_rsqf(var + GN_EPS_F);
            f32x4 v = s1 * unpack4(vm[u]) + s0 * unpack4(vl[u]) + s2 * unpack4(vh[u]);
#pragma unroll
            for (int e = 0; e < 4; ++e) o[e] = (dl[e] * rs * gg[e] + gb[e] + bon[u] * v[e]) * siluf(gate[e]);
          } else {
            float ms = rsum16(y[0] * y[0] + y[1] * y[1] + y[2] * y[2] + y[3] * y[3]) * (1.f / 64.f);
            float rs = __builtin_amdgcn_rsqf(ms + RMS_EPS_F);
#pragma unroll
            for (int e = 0; e < 4; ++e) o[e] = y[e] * rs * gg[e] * siluf(gate[e]);
          }
          uint2 ov;
          ov.x = pk2(o[0], o[1]); ov.y = pk2(o[2], o[3]);
          *(uint2*)(P.xn + XT(token, omix)) = ov;
        }
      }
    }
  }
}

#define XB_TMO      128
#define XB_XCNT(j)  (256  + 64 * (j))
#define XB_XSUB(j)  (1280 + 64 * (j))
#define XB_XGEN(j)  (2304 + 64 * (j))
#define XB_TOP      3328
#define XB_TOPGEN   3392
#define XCD_BAR_WORDS 3456
#define XB_SPIN_CAP (1u << 18)
__device__ __forceinline__ unsigned xb_ld(unsigned* p) { return __hip_atomic_load(p, __ATOMIC_RELAXED, __HIP_MEMORY_SCOPE_AGENT); }
__device__ __forceinline__ unsigned xb_add(unsigned* p, unsigned v) { return __hip_atomic_fetch_add(p, v, __ATOMIC_RELAXED, __HIP_MEMORY_SCOPE_AGENT); }
__device__ __forceinline__ unsigned xb_xcc_id() { return (unsigned)__builtin_amdgcn_s_getreg((3 << 11) | 20) & 0xFu; }
#define XB_SPIN(cond, bar) do { unsigned _sp = 0; while (cond) { __builtin_amdgcn_s_sleep(1); \
    if ((++_sp & 255u) == 0u) { if (xb_ld(&(bar)[XB_TMO])) break; if (_sp > XB_SPIN_CAP) { atomicAdd(&(bar)[XB_TMO], 1u); break; } } } } while (0)
__device__ __forceinline__ void xcd_barrier(unsigned* bar, unsigned x, unsigned nloc, unsigned nx) {
  asm volatile("s_waitcnt vmcnt(0)" ::: "memory");
  __syncthreads();
  if (threadIdx.x == 0) {
    __builtin_amdgcn_s_waitcnt(0);
    const unsigned old = xb_add(&bar[XB_XSUB(x)], 1u);
    const unsigned gen = old / nloc;
    if (old + 1u == (gen + 1u) * nloc) {
      __builtin_amdgcn_fence(__ATOMIC_RELEASE, "agent");
      asm volatile("s_waitcnt vmcnt(0)" ::: "memory");
      const unsigned og = xb_add(&bar[XB_TOP], 1u);
      const unsigned tg = og / nx;
      if (og + 1u == (tg + 1u) * nx) xb_add(&bar[XB_TOPGEN], 1u);
      else XB_SPIN(xb_ld(&bar[XB_TOPGEN]) == tg, bar);
      __builtin_amdgcn_fence(__ATOMIC_ACQUIRE, "agent");
      xb_add(&bar[XB_XGEN(x)], 1u);
      asm volatile("s_waitcnt vmcnt(0)" ::: "memory");
    } else {
      XB_SPIN(xb_ld(&bar[XB_XGEN(x)]) == gen, bar);
      __builtin_amdgcn_fence(__ATOMIC_ACQUIRE, "agent");
      asm volatile("s_waitcnt vmcnt(0)" ::: "memory");
    }
  }
  __syncthreads();
}

__device__ void p0_unit(const Params& P, int u, float* smf) {
  if (u < 2 * 1056) {
    int l = u / 1056, r = u % 1056;
    transpose_tile(P.w_in + (size_t)l * 1024 * DIN, DIN, P.WtIn + (size_t)l * DIN * 1024, r / 66, r % 66, smf);
  } else if (u < 2 * 1056 + 2 * 256) {
    int v = u - 2 * 1056;
    int l = v / 256, r = v % 256;
    transpose_tile(P.w_out + (size_t)l * 1024 * 1024, 1024, P.WtOut + (size_t)l * 1024 * 1024, r / 16, r % 16, smf);
  } else if (u < 2 * 1056 + 512 + 384) {
    int v = u - 2 * 1056 - 512;
    mod_unit(P, v / 192, v % 192, smf);
  } else {
    int v = u - 2 * 1056 - 512 - 384;
    int which = v / 24, r = v % 24;
    const float* src = (which ? P.rwkv_a_up : P.rwkv_w_up) + (size_t)(r / 6) * 64 * 384 + (r % 6) * 64;
    bf16_t* dst = P.loraT + (size_t)v * 4096;
    for (int e = opq(threadIdx.x); e < 4096; e += 256) {
      int jj = e >> 6, m = e & 63;
      dst[e] = f2bf(src[m * 384 + jj]);
    }
    __syncthreads();
  }
}

__global__ void __launch_bounds__(256, 2) fwd_megakernel(Params P) {
  cg::grid_group grid = cg::this_grid();
  __shared__ __attribute__((aligned(16))) char smem[SMEM_BYTES];
  float* smf = (float*)smem;
  const int bid = blockIdx.x, nblk = gridDim.x;
  const unsigned xcc = xb_xcc_id();
  if (threadIdx.x == 0) *(unsigned*)smem = xb_add(&P.bar[XB_XCNT(xcc)], 1u);
  __syncthreads();
  const int xslot = __builtin_amdgcn_readfirstlane(*(const unsigned*)smem);
  __syncthreads();

  const bool defer_p0 = nblk > 384;
  for (int rep = 0; rep < REP_P0; ++rep) {
    if (defer_p0) {
      for (int e = bid; e < 1272; e += nblk) {
        int u;
        if (e < 192) u = 2624 + e;
        else if (e < 216) { int le = e - 192; u = 3008 + (le / 12) * 24 + (le % 12); }
        else u = e - 216;
        p0_unit(P, u, smf);
      }
    } else {
      for (int u = bid; u < 3056; u += nblk) p0_unit(P, u, smf);
    }
  }
  if (gridDim.x == 0x7fffffffu) grid.sync();
  unsigned nloc = 0u, nxc = 0u, nlow = 0u;
  {
    __syncthreads();
    if (threadIdx.x == 0) {
      unsigned sp = 0u, a = 0u, bq = 0u, cq = 0u;
      for (;;) {
        unsigned sum = 0u;
        a = 0u; bq = 0u; cq = 0u;
#pragma unroll
        for (unsigned jx = 0; jx < 16; ++jx) {
          const unsigned c = xb_ld(&P.bar[XB_XCNT(jx)]);
          sum += c;
          bq += (c > 0u) ? 1u : 0u;
          cq += (jx < 8u && c > 0u) ? 1u : 0u;
          a = (jx == xcc) ? c : a;
        }
        if (sum == gridDim.x) break;
        __builtin_amdgcn_s_sleep(1);
        if ((++sp & 255u) == 0u) { if (xb_ld(&P.bar[XB_TMO])) break; if (sp > XB_SPIN_CAP) { atomicAdd(&P.bar[XB_TMO], 1u); break; } }
      }
      ((unsigned*)smem)[0] = a; ((unsigned*)smem)[1] = bq; ((unsigned*)smem)[2] = cq;
    }
    __syncthreads();
    nloc = ((const unsigned*)smem)[0]; nxc = ((const unsigned*)smem)[1]; nlow = ((const unsigned*)smem)[2];
    __syncthreads();
    nlow = __builtin_amdgcn_readfirstlane(nlow);
    nloc = __builtin_amdgcn_readfirstlane(nloc > 0u ? nloc : 1u);
    nxc = __builtin_amdgcn_readfirstlane(nxc > 0u ? nxc : 1u);
  }
  xcd_barrier(P.bar, xcc, nloc, nxc);

  for (int l = 0; l < 2; ++l) {
    ln_phase(P, l);
    xcd_barrier(P.bar, xcc, nloc, nxc);
    for (int rep = 0; rep < REP_G1; ++rep) {
      if (nxc == 8u && nlow == 8u) {
        const int xcd = (int)xcc, slot = xslot, nslot = (int)nloc;
        for (int i = slot; i < 36 * 33; i += nslot) {
          int mg = i / 132, r = i % 132;
          int nt = r >> 2, mt = xcd * 36 + mg * 4 + (r & 3);
          gemm_tile<0>(P, l, P.xn, P.WtIn + (size_t)l * DIN * 1024, mt * 128, nt * 128, smem);
        }
      } else {
        for (int t = bid; t < 288 * 33; t += nblk) {
          int mt = t / 33, nt = t % 33;
          gemm_tile<0>(P, l, P.xn, P.WtIn + (size_t)l * DIN * 1024, mt * 128, nt * 128, smem);
        }
      }
    }
    xcd_barrier(P.bar, xcc, nloc, nxc);
    const bool grid512 = (nblk == 512);
    int sidx = -1, nside = 0;
    if (grid512) { nside = 128; sidx = (bid >= 192 && bid < 256) ? (bid - 192) : ((bid >= 448) ? (64 + bid - 448) : -1); }
    else if (nblk > 384) { nside = nblk - 384; sidx = (bid >= 384) ? (bid - 384) : -1; }
    for (int rep = 0; rep < REP_SCAN; ++rep)
    for (int u0 = bid; u0 < (grid512 ? 512 : 384); u0 += nblk) {
      int u = u0;
      if (grid512) {
        if (u0 < 192) u = u0;
        else if (u0 >= 256 && u0 < 448) u = 192 + (u0 - 256);
        else continue;
      }
      int type = u / 192, rem = u % 192;
      int d = rem / 96, b = (rem % 96) / 6, h = rem % 6;
      if (type == 0) rwkv_unit2(P, l, b, h, d, smem, rem);
      else hgrn_unit2(P, l, b, h, d, smem);
    }
    const bool pool_in_scan = nblk > 384;
    if (pool_in_scan && sidx >= 0) {
      const int ntile_p = (l == 0) ? 576 : 512;
      for (int t = sidx; t < ntile_p; t += nside) mix_tile(P, l, t, smf, 1);
      if (l == 0) {
        for (int f = sidx; f < 1784; f += nside) {
          int u;
          if (f < 1056) u = 1056 + f;
          else if (f < 1568) u = 2112 + (f - 1056);
          else if (f < 1760) u = 2624 + 192 + (f - 1568);
          else { int lf = f - 1760; u = 3008 + (lf / 12) * 24 + 12 + (lf % 12); }
          p0_unit(P, u, smf);
        }
      }
    }
    xcd_barrier(P.bar, xcc, nloc, nxc);
    {
      int ntile = (l == 0) ? 576 : 512;
      for (int rep = 0; rep < REP_MIX; ++rep)
      for (int t = bid; t < ntile; t += nblk) mix_tile(P, l, t, smf, (nblk > 384) ? 2 : 3);
    }
    xcd_barrier(P.bar, xcc, nloc, nxc);
    {
      int nmt = (l == 0) ? 288 : 256;
      for (int rep = 0; rep < ((l == 0) ? REP_G2 : 1); ++rep) {
        if (nxc == 8u && nlow == 8u) {
          const int xcd = (int)xcc, slot = xslot, nslot = (int)nloc, mpx = nmt >> 3;
          for (int i = slot; i < mpx * 8; i += nslot) {
            int mt = xcd * mpx + (i >> 3), nt = i & 7;
            gemm_tile<1>(P, l, P.xn, P.WtOut + (size_t)l * 1024 * 1024, mt * 128, nt * 128, smem);
          }
        } else {
          for (int t = bid; t < nmt * 8; t += nblk) {
            int mt = t / 8, nt = t % 8;
            gemm_tile<1>(P, l, P.xn, P.WtOut + (size_t)l * 1024 * 1024, mt * 128, nt * 128, smem);
          }
        }
      }
    }
    xcd_barrier(P.bar, xcc, nloc, nxc);
  }
  final_ln_phase(P);
}

extern "C" void kernel_launch(void* const* d_in, const int* in_sizes, int n_in, void* d_out, int out_size, void* d_ws,
                              size_t ws_size, hipStream_t stream) {
  static int grid_blocks = 0;
  if (!grid_blocks) {
    int dev = 0, cus = 0, per_cu = 0;
    hipGetDevice(&dev);
    hipDeviceGetAttribute(&cus, hipDeviceAttributeMultiprocessorCount, dev);
    hipOccupancyMaxActiveBlocksPerMultiprocessor(&per_cu, fwd_megakernel, 256, 0);
    if (per_cu > 2) per_cu = 2;
    grid_blocks = cus * per_cu;
  }
  Params p{};
  const float* const* in = (const float* const*)d_in;
  p.x = in[0]; p.c = in[1]; p.ctx = in[2]; p.c_ctx = in[3]; p.mod_w = in[4]; p.mod_b = in[5]; p.w_in = in[6];
  p.rwkv_shift = in[7]; p.pool_w = in[8]; p.pool_scale = in[9]; p.rwkv_w0 = in[10]; p.rwkv_w_up = in[11];
  p.rwkv_a0 = in[12]; p.rwkv_a_up = in[13]; p.rwkv_k_k = in[14]; p.rwkv_k_a = in[15]; p.rwkv_r_k = in[16];
  p.rwkv_gn_g = in[17]; p.rwkv_gn_b = in[18]; p.hgrn_lb = in[19]; p.hgrn_norm_g = in[20]; p.w_out = in[21];
  p.ln_g = in[22]; p.ln_b = in[23];
  p.out = (float*)d_out;
  char* ws = (char*)d_ws;
  size_t off = 0;
  auto take = [&](size_t bytes) { char* r = ws + off; off += (bytes + 255) & ~(size_t)255; return r; };
  p.WtIn = (bf16_t*)take((size_t)2 * DIN * 1024 * 2);
  p.WtOut = (bf16_t*)take((size_t)2 * 1024 * 1024 * 2);
  p.mod = (float*)take((size_t)2 * 17 * 3072 * 4);
  p.xn = (bf16_t*)take((size_t)NTOK * 1024 * 2);
  p.p = (bf16_t*)take((size_t)NTOK * DIN * 2);
  p.yrec = (bf16_t*)take((size_t)NTOK * YREC * 2);
  p.bonus = (float*)take((size_t)NTOK * 12 * 4);
  p.loraT = (bf16_t*)take((size_t)48 * 4096 * 2);
  p.ring = take((size_t)192 * 4 * RSLOT);
  p.bar = (unsigned*)take((size_t)XCD_BAR_WORDS * 4);
  p.hprectx = (float*)p.p;
  if (off > ws_size) { fprintf(stderr, "workspace too small: need %zu have %zu\n", off, ws_size); return; }
  hipMemsetAsync(p.bar, 0, (size_t)XCD_BAR_WORDS * 4, stream);
  void* args[] = {&p};
  hipError_t e = hipLaunchCooperativeKernel((void*)fwd_megakernel, dim3(grid_blocks), dim3(256), args, 0, stream);
  if (e != hipSuccess) fprintf(stderr, "cooperative launch failed: %s (grid %d)\n", hipGetErrorString(e), grid_blocks);
}
```

```cpp
#include <hip/hip_runtime.h>
#include <hip/hip_bf16.h>
#include <hip/hip_cooperative_groups.h>
#include <cstdio>
namespace cg = cooperative_groups;

typedef unsigned short bf16_t;
using bf16x8 = __attribute__((ext_vector_type(8))) short;
using f32x4 = __attribute__((ext_vector_type(4))) float;
using u32x4 = __attribute__((ext_vector_type(4))) unsigned;

#define DM 1024
#define NB 16
#define SEQL 2048
#define CTXL 256
#define NLAT 32768
#define NCTX 4096
#define NTOK 36864
#define DIN 4224
#define ALPHA_F 1.4142135623730951f
#define LN_EPS_F 1e-5f
#define GN_EPS_F 64e-5f
#define RMS_EPS_F 1e-6f
#define YREC 1536
#define PTOFF(col) ((((col) >> 7) * NTOK) * 128 + ((col) & 127))
#define PT(tok, col) ((size_t)PTOFF(col) + (size_t)(tok) * 128)
#define XT(row, k) ((size_t)(((k) >> 6) * NTOK + (row)) * 64 + ((k) & 63))
#define SMEM_BYTES 65536
#ifndef REP_P0
#define REP_P0 1
#endif
#ifndef REP_LN
#define REP_LN 1
#endif
#ifndef REP_G1
#define REP_G1 1
#endif
#ifndef REP_SCAN
#define REP_SCAN 1
#endif
#ifndef REP_MIX
#define REP_MIX 1
#endif
#ifndef REP_G2
#define REP_G2 1
#endif

struct Params {
  const float *x, *c, *ctx, *c_ctx, *mod_w, *mod_b, *w_in, *rwkv_shift, *pool_w, *pool_scale,
      *rwkv_w0, *rwkv_w_up, *rwkv_a0, *rwkv_a_up, *rwkv_k_k, *rwkv_k_a, *rwkv_r_k, *rwkv_gn_g, *rwkv_gn_b,
      *hgrn_lb, *hgrn_norm_g, *w_out, *ln_g, *ln_b;
  float* out;
  bf16_t *WtIn, *WtOut, *xn, *p, *yrec;
  float *mod, *bonus, *hprectx;
  bf16_t* loraT;
  char* ring;
  unsigned* bar;
};

__device__ __forceinline__ float bf2f(bf16_t v) { return __uint_as_float(((unsigned)v) << 16); }
__device__ __forceinline__ bf16_t f2bf(float f) {
  unsigned u = __float_as_uint(f);
  u += 0x7fffu + ((u >> 16) & 1u);
  return (bf16_t)(u >> 16);
}
#define DPPF(v, ctrl) __builtin_bit_cast(float, __builtin_amdgcn_update_dpp(0, __builtin_bit_cast(int, (v)), (ctrl), 0xf, 0xf, true))
__device__ __forceinline__ float rsum16(float v) {
  v += DPPF(v, 0xB1);
  v += DPPF(v, 0x4E);
  v += DPPF(v, 0x141);
  v += DPPF(v, 0x140);
  return v;
}
__device__ __forceinline__ float wsum(float v) {
  v = rsum16(v);
  int iv = __builtin_bit_cast(int, v);
  float a = __builtin_bit_cast(float, __builtin_amdgcn_readlane(iv, 0));
  float b = __builtin_bit_cast(float, __builtin_amdgcn_readlane(iv, 16));
  float c = __builtin_bit_cast(float, __builtin_amdgcn_readlane(iv, 32));
  float d = __builtin_bit_cast(float, __builtin_amdgcn_readlane(iv, 48));
  return (a + b) + (c + d);
}
__device__ __forceinline__ int opq(int v) { asm volatile("" : "+v"(v)); return v; }
__device__ __forceinline__ float frcp(float x) { return __builtin_amdgcn_rcpf(x); }
__device__ __forceinline__ float siluf(float x) { return x * frcp(1.f + __expf(-x)); }
__device__ __forceinline__ float sigmf(float x) { return frcp(1.f + __expf(-x)); }
__device__ __forceinline__ float ftanh(float x) { return 1.f - 2.f * frcp(1.f + __expf(2.f * x)); }

__device__ void transpose_tile(const float* __restrict__ W, int N, bf16_t* __restrict__ Wt, int kt, int nt, float* sm) {
  int tid = opq(threadIdx.x);
  {
    float vals[16];
#pragma unroll
    for (int k = 0; k < 16; ++k) {
      int e = tid + k * 256;
      int kk = e >> 6, nn = e & 63;
      vals[k] = W[(size_t)(kt * 64 + kk) * N + nt * 64 + nn];
    }
#pragma unroll
    for (int k = 0; k < 16; ++k) {
      int e = tid + k * 256;
      sm[(e >> 6) * 65 + (e & 63)] = vals[k];
    }
  }
  __syncthreads();
  for (int e = tid; e < 4096; e += 256) {
    int nn = e >> 6, kk = e & 63;
    Wt[((size_t)kt * N + nt * 64 + nn) * 64 + kk] = f2bf(sm[kk * 65 + nn]);
  }
  __syncthreads();
}

__device__ void mod_unit(const Params& P, int l, int cb, float* sm) {
  int tid = opq(threadIdx.x), j = tid & 15, kp = tid >> 4;
  float acc[17];
#pragma unroll
  for (int r = 0; r < 17; ++r) acc[r] = 0.f;
  const float* W = P.mod_w + (size_t)l * 1024 * 3072 + cb * 16 + j;
  for (int pass = 0; pass < 2; ++pass) {
    for (int e = tid; e < 17 * 512; e += 256) {
      int r = e >> 9, k = (e & 511) + pass * 512;
      float v = (r < 16) ? P.c[r * 1024 + k] : P.c_ctx[k];
      sm[e] = siluf(v);
    }
    __syncthreads();
    {
      const int k0 = kp * 32;
      float wv[32];
#pragma unroll
      for (int u = 0; u < 32; ++u) wv[u] = W[(size_t)(pass * 512 + k0 + u) * 3072];
#pragma unroll
      for (int u = 0; u < 32; ++u) {
#pragma unroll
        for (int r = 0; r < 17; ++r) acc[r] += sm[r * 512 + k0 + u] * wv[u];
      }
    }
    __syncthreads();
  }
#pragma unroll
  for (int r = 0; r < 17; ++r) sm[(kp * 17 + r) * 16 + j] = acc[r];
  __syncthreads();
  for (int e = tid; e < 17 * 16; e += 256) {
    int r = e >> 4, jj = e & 15;
    float s0 = 0.f;
#pragma unroll
    for (int k = 0; k < 16; ++k) s0 += sm[(k * 17 + r) * 16 + jj];
    int col = cb * 16 + jj;
    P.mod[((size_t)l * 17 + r) * 3072 + col] = s0 + P.mod_b[l * 3072 + col];
  }
  __syncthreads();
}

__device__ __forceinline__ void ln16(float (&v)[16]) {
  float s = 0.f;
#pragma unroll
  for (int i = 0; i < 16; ++i) s += v[i];
  float mu = wsum(s) * (1.f / 1024.f);
  float q = 0.f;
#pragma unroll
  for (int i = 0; i < 16; ++i) { v[i] -= mu; q += v[i] * v[i]; }
  float rs = rsqrtf(wsum(q) * (1.f / 1024.f) + LN_EPS_F);
#pragma unroll
  for (int i = 0; i < 16; ++i) v[i] *= rs;
}

__device__ void ln_phase(const Params& P, int l) {
  const int tidq = opq(threadIdx.x);
  int lane = tidq & 63;
  int gw = (blockIdx.x * 256 + tidq) >> 6, nw = (gridDim.x * 256) >> 6;
#pragma unroll 2
  for (int row = gw; row < NTOK; row += nw) {
    const float* src;
    int r;
    if (row < NLAT) { src = (l == 0 ? P.x : P.out) + (size_t)row * 1024; r = row >> 11; }
    else { src = (l == 0 ? P.ctx : P.hprectx) + (size_t)(row - NLAT) * 1024; r = 16; }
    float v[16];
#pragma unroll
    for (int i = 0; i < 4; ++i) {
      float4 t = *(const float4*)(src + i * 256 + lane * 4);
      v[i * 4] = t.x; v[i * 4 + 1] = t.y; v[i * 4 + 2] = t.z; v[i * 4 + 3] = t.w;
    }
    if (l > 0) {
      ln16(v);
#pragma unroll
      for (int i = 0; i < 4; ++i) {
        float4 g = *(const float4*)(P.ln_g + (l - 1) * 1024 + i * 256 + lane * 4);
        float4 bb = *(const float4*)(P.ln_b + (l - 1) * 1024 + i * 256 + lane * 4);
        v[i * 4] = v[i * 4] * g.x + bb.x; v[i * 4 + 1] = v[i * 4 + 1] * g.y + bb.y;
        v[i * 4 + 2] = v[i * 4 + 2] * g.z + bb.z; v[i * 4 + 3] = v[i * 4 + 3] * g.w + bb.w;
      }
      if (row < NLAT) {
#pragma unroll
        for (int i = 0; i < 4; ++i)
          *(float4*)(P.out + (size_t)row * 1024 + i * 256 + lane * 4) = make_float4(v[i * 4], v[i * 4 + 1], v[i * 4 + 2], v[i * 4 + 3]);
      }
    }
    ln16(v);
    const float* md = P.mod + ((size_t)l * 17 + r) * 3072;
#pragma unroll
    for (int i = 0; i < 4; ++i) {
      float4 sh = *(const float4*)(md + i * 256 + lane * 4);
      float4 sc = *(const float4*)(md + 1024 + i * 256 + lane * 4);
      ushort4 o;
      o.x = f2bf(v[i * 4] * (1.f + sc.x) + sh.x);
      o.y = f2bf(v[i * 4 + 1] * (1.f + sc.y) + sh.y);
      o.z = f2bf(v[i * 4 + 2] * (1.f + sc.z) + sh.z);
      o.w = f2bf(v[i * 4 + 3] * (1.f + sc.w) + sh.w);
      *(ushort4*)(P.xn + XT(row, i * 256 + lane * 4)) = o;
    }
  }
}

__device__ void final_ln_phase(const Params& P) {
  const int tidq = opq(threadIdx.x);
  int lane = tidq & 63;
  int gw = (blockIdx.x * 256 + tidq) >> 6, nw = (gridDim.x * 256) >> 6;
  for (int row = gw; row < NLAT; row += nw) {
    float* src = P.out + (size_t)row * 1024;
    float v[16];
#pragma unroll
    for (int i = 0; i < 4; ++i) {
      float4 t = *(const float4*)(src + i * 256 + lane * 4);
      v[i * 4] = t.x; v[i * 4 + 1] = t.y; v[i * 4 + 2] = t.z; v[i * 4 + 3] = t.w;
    }
    ln16(v);
#pragma unroll
    for (int i = 0; i < 4; ++i) {
      float4 g = *(const float4*)(P.ln_g + 1024 + i * 256 + lane * 4);
      float4 bb = *(const float4*)(P.ln_b + 1024 + i * 256 + lane * 4);
      *(float4*)(src + i * 256 + lane * 4) = make_float4(v[i * 4] * g.x + bb.x, v[i * 4 + 1] * g.y + bb.y,
                                                          v[i * 4 + 2] * g.z + bb.z, v[i * 4 + 3] * g.w + bb.w);
    }
  }
}

typedef __bf16 bf2e_t __attribute__((ext_vector_type(2)));
typedef float fl2e_t __attribute__((ext_vector_type(2)));
__device__ __forceinline__ unsigned pk2(float a, float b) {
  fl2e_t f = {a, b};
  bf2e_t h = __builtin_convertvector(f, bf2e_t);
  return __builtin_bit_cast(unsigned, h);
}
template <int MODE>
__device__ void gemm_tile(const Params& P, int l, const bf16_t* __restrict__ A, const bf16_t* __restrict__ Bt,
                          int row0, int col0, char* smem) {
  const int tid = opq(threadIdx.x), lane = tid & 63, wave = tid >> 6, wr = wave >> 1, wc = wave & 1, fr = lane & 15, fq = lane >> 4;
  f32x4 acc[4][4];
#pragma unroll
  for (int m = 0; m < 4; ++m)
#pragma unroll
    for (int n = 0; n < 4; ++n) acc[m][n] = f32x4{0.f, 0.f, 0.f, 0.f};
  u32x4 ra0[4], rb0[4], ra1[4], rb1[4];
  const int crow = tid >> 3, c16 = tid & 7;
  const int NBR = (MODE == 0) ? DIN : 1024;
  const bf16_t* Ag = A + (size_t)(row0 + crow) * 64 + c16 * 8;
  const bf16_t* Bg = Bt + (size_t)(col0 + crow) * 64 + c16 * 8;
#define GLOAD(RA, RB, kt)                                                                           \
  _Pragma("unroll") for (int i = 0; i < 4; ++i) {                                                   \
    asm volatile("global_load_dwordx4 %0, %1, off" : "=v"(RA[i]) : "v"(Ag + (size_t)i * 32 * 64 + (size_t)(kt) * NTOK * 64)); \
    asm volatile("global_load_dwordx4 %0, %1, off" : "=v"(RB[i]) : "v"(Bg + (size_t)i * 32 * 64 + (size_t)(kt) * NBR * 64)); \
  }
#define LSTORE(RA, RB, s)                                                                  \
  _Pragma("unroll") for (int i = 0; i < 4; ++i) {                                          \
    *(u32x4*)(smem + (s) * 32768 + (crow + i * 32) * 128 + ((c16 ^ (((crow + i * 32) >> 1) & 7)) << 4)) = RA[i];          \
    *(u32x4*)(smem + (s) * 32768 + 16384 + (crow + i * 32) * 128 + ((c16 ^ (((crow + i * 32) >> 1) & 7)) << 4)) = RB[i];  \
  }
#define COMPUTE(s)                                                                                                   \
  {                                                                                                                  \
    const char* sA = smem + (s) * 32768;                                                                             \
    const char* sB = sA + 16384;                                                                                     \
    bf16x8 af0[4], bf0[4], af1[4], bf1[4];                                                                           \
    _Pragma("unroll") for (int m = 0; m < 4; ++m)                                                                    \
      af0[m] = *(const bf16x8*)(sA + (wr * 64 + m * 16 + fr) * 128 + (((0 + fq) ^ ((fr >> 1) & 7)) << 4));           \
    _Pragma("unroll") for (int n = 0; n < 4; ++n)                                                                    \
      bf0[n] = *(const bf16x8*)(sB + (wc * 64 + n * 16 + fr) * 128 + (((0 + fq) ^ ((fr >> 1) & 7)) << 4));           \
    _Pragma("unroll") for (int m = 0; m < 4; ++m)                                                                    \
      af1[m] = *(const bf16x8*)(sA + (wr * 64 + m * 16 + fr) * 128 + (((4 + fq) ^ ((fr >> 1) & 7)) << 4));           \
    _Pragma("unroll") for (int n = 0; n < 4; ++n)                                                                    \
      bf1[n] = *(const bf16x8*)(sB + (wc * 64 + n * 16 + fr) * 128 + (((4 + fq) ^ ((fr >> 1) & 7)) << 4));           \
    __builtin_amdgcn_sched_barrier(0);                                                                               \
    __builtin_amdgcn_s_setprio(1);                                                                                   \
    _Pragma("unroll") for (int m = 0; m < 4; ++m)                                                                    \
      _Pragma("unroll") for (int n = 0; n < 4; ++n)                                                                  \
        acc[m][n] = __builtin_amdgcn_mfma_f32_16x16x32_bf16(bf0[n], af0[m], acc[m][n], 0, 0, 0);                     \
    _Pragma("unroll") for (int m = 0; m < 4; ++m)                                                                    \
      _Pragma("unroll") for (int n = 0; n < 4; ++n)                                                                  \
        acc[m][n] = __builtin_amdgcn_mfma_f32_16x16x32_bf16(bf1[n], af1[m], acc[m][n], 0, 0, 0);                     \
    __builtin_amdgcn_s_setprio(0);                                                                                   \
  }
  GLOAD(ra0, rb0, 0);
  asm volatile("s_waitcnt vmcnt(0)" ::: "memory");
  LSTORE(ra0, rb0, 0);
  GLOAD(ra0, rb0, 1);
  __syncthreads();
  for (int kt = 0; kt < 16; kt += 2) {
    if (kt + 2 < 16) { GLOAD(ra1, rb1, kt + 2); }
    __builtin_amdgcn_sched_barrier(0);
    COMPUTE(0);
    __builtin_amdgcn_sched_barrier(0);
    if (kt + 2 < 16) asm volatile("s_waitcnt vmcnt(8)" ::: "memory");
    else asm volatile("s_waitcnt vmcnt(0)" ::: "memory");
    LSTORE(ra0, rb0, 1);
    __syncthreads();
    if (kt + 3 < 16) { GLOAD(ra0, rb0, kt + 3); }
    __builtin_amdgcn_sched_barrier(0);
    COMPUTE(1);
    __builtin_amdgcn_sched_barrier(0);
    if (kt + 2 < 16) {
      if (kt + 3 < 16) asm volatile("s_waitcnt vmcnt(8)" ::: "memory");
      else asm volatile("s_waitcnt vmcnt(0)" ::: "memory");
      LSTORE(ra1, rb1, 0);
    }
    __syncthreads();
  }
#undef COMPUTE
#undef GLOAD
#undef LSTORE
#pragma unroll
  for (int m = 0; m < 4; ++m) {
    int row = row0 + wr * 64 + m * 16 + fr;
#pragma unroll
    for (int n = 0; n < 4; ++n) {
      int col = col0 + wc * 64 + n * 16 + fq * 4;
      if (MODE == 0) {
        uint2 o;
        o.x = pk2(acc[m][n][0], acc[m][n][1]); o.y = pk2(acc[m][n][2], acc[m][n][3]);
        *(uint2*)(smem + (row - row0) * 272 + (col - col0) * 2) = o;
      } else {
        const float* hsrc;
        float* dst;
        int r;
        if (row < NLAT) {
          hsrc = (l == 0 ? P.x : P.out) + (size_t)row * 1024 + col;
          dst = P.out + (size_t)row * 1024 + col;
          r = row >> 11;
        } else {
          hsrc = P.ctx + (size_t)(row - NLAT) * 1024 + col;
          dst = P.hprectx + (size_t)(row - NLAT) * 1024 + col;
          r = 16;
        }
        float4 hv = *(const float4*)hsrc;
        float4 gt = *(const float4*)(P.mod + ((size_t)l * 17 + r) * 3072 + 2048 + col);
        float4 o;
        o.x = ALPHA_F * hv.x + gt.x * acc[m][n][0];
        o.y = ALPHA_F * hv.y + gt.y * acc[m][n][1];
        o.z = ALPHA_F * hv.z + gt.z * acc[m][n][2];
        o.w = ALPHA_F * hv.w + gt.w * acc[m][n][3];
        *(float4*)dst = o;
      }
    }
  }
  if (MODE == 0) {
    __syncthreads();
#pragma unroll
    for (int i = 0; i < 8; ++i) {
      const int c = tid + 256 * i, rr = c >> 4, cc = c & 15;
      u32x4 v = *(const u32x4*)(smem + rr * 272 + cc * 16);
      *(u32x4*)(P.p + PT(row0 + rr, col0) + cc * 8) = v;
    }
    __syncthreads();
  }
}

typedef __bf16 bf2_t __attribute__((ext_vector_type(2)));
typedef float fl2_t __attribute__((ext_vector_type(2)));
using bf16x4 = __attribute__((ext_vector_type(4))) short;
__device__ __forceinline__ bf16_t f2bfh(float a) { return (bf16_t)(pk2(a, 0.f) & 0xffffu); }
__device__ __forceinline__ float rlane(float x, int l) {
  return __builtin_bit_cast(float, __builtin_amdgcn_readlane(__builtin_bit_cast(int, x), l));
}
__device__ __forceinline__ void wave_sync() {
  asm volatile("s_waitcnt lgkmcnt(0)" ::: "memory");
  __builtin_amdgcn_wave_barrier();
}
union U8 { bf16x8 v; unsigned u[4]; uint4 q; };
union U4 { bf16x4 v; unsigned u[2]; uint2 q; };
__device__ __forceinline__ bf16x8 pack8(f32x4 a, f32x4 b) {
  U8 r;
  r.u[0] = pk2(a[0], a[1]); r.u[1] = pk2(a[2], a[3]); r.u[2] = pk2(b[0], b[1]); r.u[3] = pk2(b[2], b[3]);
  return r.v;
}
__device__ __forceinline__ f32x4 unpack4(uint2 w) {
  f32x4 r;
  r[0] = __uint_as_float(w.x << 16); r[1] = __uint_as_float(w.x & 0xffff0000u);
  r[2] = __uint_as_float(w.y << 16); r[3] = __uint_as_float(w.y & 0xffff0000u);
  return r;
}
#define RSLOT 14592
using u32x2 = __attribute__((ext_vector_type(2))) unsigned;
#define GLD(T, p) (*(const __attribute__((address_space(1))) T*)(p))
#define GST(T, p, v) (*(__attribute__((address_space(1))) T*)(p) = (v))
#define MFMA32(a, b, c) __builtin_amdgcn_mfma_f32_16x16x32_bf16(a, b, c, 0, 0, 0)
#define MFMA16(a, b, c) __builtin_amdgcn_mfma_f32_16x16x16bf16_1k(a, b, c, 0, 0, 0)

__device__ void rwkv_unit2(const Params& P, int l, int b, int h, int d, char* smem, int unit) {
  const int tid = opq(threadIdx.x), lane0 = tid & 63, wave = __builtin_amdgcn_readfirstlane(tid >> 6);
  char* wsm = smem + wave * 16384;
  bf16_t* Q1 = (bf16_t*)wsm;
  bf16_t* Q2 = (bf16_t*)(wsm + 2048);
  bf16_t* Q3 = (bf16_t*)(wsm + 4096);
  bf16_t* Q4 = (bf16_t*)(wsm + 6144);
  float* F = (float*)(wsm + 8192);
  char* ring0 = P.ring + (size_t)unit * 4 * RSLOT;
  const bf16_t* WT = P.loraT + (size_t)((l * 2 + d) * 6 + h) * 4096;
  const bf16_t* AT = WT + (size_t)24 * 4096;
  const float w0j = P.rwkv_w0[(l * 2 + d) * 384 + h * 64 + lane0];
  const float a0j = P.rwkv_a0[(l * 2 + d) * 384 + h * 64 + lane0];
  const float kkj = P.rwkv_k_k[l * 384 + h * 64 + lane0];
  const float kaj = P.rwkv_k_a[l * 384 + h * 64 + lane0];
  const float rkj = P.rwkv_r_k[((l * 2 + d) * 6 + h) * 64 + lane0];
  f32x4 accS[4];
#pragma unroll
  for (int mt = 0; mt < 4; ++mt) accS[mt] = f32x4{0.f, 0.f, 0.f, 0.f};

  for (int rnd = 0; rnd < 36; ++rnd) {
    int L, base;
    if (rnd < 4) { L = CTXL; base = NLAT + b * CTXL; }
    else { L = SEQL; base = b * SEQL; }
    const int rr0 = (rnd < 4) ? rnd : rnd - 4;
    const int lane = opq(lane0), fr = lane & 15, q = lane >> 4, j = lane;
    const int offA = (j >> 5) * 1024 + ((j >> 2) & 3) * 256 + ((j >> 4) & 1) * 8 + (j & 3) * 2;
    char* ring = ring0;
    asm volatile("" : "+s"(ring));
    char* myslot = ring + wave * RSLOT;
    {
      const int spos = (rr0 * 4 + wave) * 16;
      const int t0 = d ? (L - 1 - spos) : spos;
      const int tlo = d ? (t0 - 15) : t0;
      float rv[16], kv[16], vv[16];
      {
        __amdgpu_buffer_rsrc_t prs = __builtin_amdgcn_make_buffer_rsrc((void*)P.p, 0, 0x7ffffff0, 0x00020000);
        int uc_[5];
        uc_[0] = 1152 + d * 64; uc_[1] = 1280 + d * 64; uc_[2] = h * 64; uc_[3] = 384 + h * 64; uc_[4] = 768 + h * 64;
        const bool vprev = d ? (t0 < L - 1) : (t0 > 0);
        const bool vnext = d ? (t0 - 15 > 0) : (t0 + 15 < L - 1);
        const int tmin = d ? (t0 - 16) : (t0 - 1);
        char* stg = wsm + 4096;
        const int lrow = opq(lane) >> 3, lc8 = lane & 7;
        u32x4 pcs[5][3];
#pragma unroll
        for (int g = 0; g < 5; ++g) {
          const int so = __builtin_amdgcn_readfirstlane((PTOFF(256 + uc_[g]) + (base + tmin) * 128) * 2);
#pragma unroll
          for (int k = 0; k < 3; ++k) {
            const int rr = lrow + 8 * k;
            const int ridx = d ? (17 - rr) : rr;
            pcs[g][k] = u32x4{0u, 0u, 0u, 0u};
            const bool ok = (rr < 18) && !((rr == 0) && !vprev) && !((rr == 17) && !vnext);
            if (ok) pcs[g][k] = __builtin_amdgcn_raw_buffer_load_b128(prs, ridx * 256 + lc8 * 16, so, 0);
          }
        }
#pragma unroll
        for (int g = 0; g < 5; ++g)
#pragma unroll
          for (int k = 0; k < 3; ++k) {
            const int rr = lrow + 8 * k;
            if (rr < 18) *(u32x4*)(stg + (g * 18 + rr) * 128 + lc8 * 16) = pcs[g][k];
          }
        wave_sync();
        bf16_t raw[5][18];
#pragma unroll
        for (int g = 0; g < 5; ++g)
#pragma unroll
          for (int rr = 0; rr < 18; ++rr) raw[g][rr] = *(const bf16_t*)(stg + (g * 18 + rr) * 128 + j * 2);
        wave_sync();
        __builtin_amdgcn_sched_barrier(0);
#pragma unroll
        for (int g = 0; g < 5; ++g) {
          const int uc = uc_[g] + j;
          const float ca = P.rwkv_shift[(l * 3 + 0) * 1408 + uc], c1 = P.rwkv_shift[(l * 3 + 1) * 1408 + uc],
                      cb = P.rwkv_shift[(l * 3 + 2) * 1408 + uc];
          const float cprev = d ? cb : ca, cnext = d ? ca : cb;
#pragma unroll
          for (int i = 0; i < 16; ++i) {
            float val = cprev * bf2f(raw[g][i]) + c1 * bf2f(raw[g][i + 1]) + cnext * bf2f(raw[g][i + 2]);
            if (g == 0) Q1[i * 64 + j] = f2bfh(ftanh(val));
            else if (g == 1) Q2[i * 64 + j] = f2bfh(val);
            else if (g == 2) rv[i] = val;
            else if (g == 3) kv[i] = val;
            else vv[i] = val;
          }
        }
      }
      wave_sync();
      float* G = F + 1024;
#pragma unroll
      for (int nt = 0; nt < 4; ++nt) {
        f32x4 acc = {0.f, 0.f, 0.f, 0.f}, acc2 = acc;
#pragma unroll
        for (int s = 0; s < 2; ++s) {
          bf16x8 a = *(const bf16x8*)(Q1 + fr * 64 + s * 32 + q * 8);
          bf16x8 bw = *(const bf16x8*)(WT + (16 * nt + fr) * 64 + s * 32 + q * 8);
          acc = MFMA32(a, bw, acc);
          bf16x8 a2 = *(const bf16x8*)(Q2 + fr * 64 + s * 32 + q * 8);
          bf16x8 bw2 = *(const bf16x8*)(AT + (16 * nt + fr) * 64 + s * 32 + q * 8);
          acc2 = MFMA32(a2, bw2, acc2);
        }
#pragma unroll
        for (int jj = 0; jj < 4; ++jj) {
          F[(4 * q + jj) * 64 + 16 * nt + fr] = acc[jj];
          G[(4 * q + jj) * 64 + 16 * nt + fr] = acc2[jj];
        }
      }
      wave_sync();
      float kt[16];
      float khv[16], bhv[16];
      {
        float av[16], ssv[16];
        {
          float* R1 = (float*)Q1;
          float* R2 = (float*)Q3;
          float sq[16], bt[16];
#pragma unroll
          for (int i = 0; i < 16; ++i) {
            float a = sigmf(G[i * 64 + j] + a0j);
            av[i] = a;
            float kkv = kv[i] * kkj;
            sq[i] = kkv * kkv;
            bt[i] = rv[i] * (kv[i] * (1.f + (a - 1.f) * kaj)) * rkj;
          }
#pragma unroll
          for (int c4 = 0; c4 < 4; ++c4) {
            *(f32x4*)(R2 + j * 16 + c4 * 4) = f32x4{sq[c4 * 4], sq[c4 * 4 + 1], sq[c4 * 4 + 2], sq[c4 * 4 + 3]};
            *(f32x4*)(R1 + j * 16 + c4 * 4) = f32x4{bt[c4 * 4], bt[c4 * 4 + 1], bt[c4 * 4 + 2], bt[c4 * 4 + 3]};
          }
          wave_sync();
          float s1 = 0.f, s2 = 0.f;
#pragma unroll
          for (int k = 0; k < 16; ++k) {
            s1 += R2[(q * 16 + k) * 16 + fr];
            s2 += R1[(q * 16 + k) * 16 + fr];
          }
          s1 += __shfl_xor(s1, 16); s1 += __shfl_xor(s1, 32);
          s2 += __shfl_xor(s2, 16); s2 += __shfl_xor(s2, 32);
          if (lane < 16) {
            G[lane] = s1;
            const int tb = d ? (t0 - lane) : (t0 + lane);
            P.bonus[(size_t)(base + tb) * 12 + d * 6 + h] = s2;
          }
          wave_sync();
#pragma unroll
          for (int c4 = 0; c4 < 4; ++c4) {
            f32x4 x = *(const f32x4*)(G + c4 * 4);
            ssv[c4 * 4] = x[0]; ssv[c4 * 4 + 1] = x[1]; ssv[c4 * 4 + 2] = x[2]; ssv[c4 * 4 + 3] = x[3];
          }
          wave_sync();
        }
        float g = 0.f, eg = 1.f;
#pragma unroll
        for (int i = 0; i < 16; ++i) {
          float wl = F[i * 64 + j] + w0j;
          float lw = -0.60653066f * frcp(1.f + __expf(-wl));
          const float egp = eg;
          g += lw;
          float a = av[i];
          float kkv = kv[i] * kkj;
          float kk = kkv * __builtin_amdgcn_rsqf(ssv[i] + 1e-12f);
          float kmod = kv[i] * (1.f + (a - 1.f) * kaj);
          float bb = a * kk;
          eg = __expf(g);
          float eng = frcp(eg);
          kt[i] = kk * egp;
          khv[i] = kmod * eng;
          bhv[i] = bb * eng;
          Q1[i * 64 + j] = f2bfh(kt[i]);
          Q2[i * 64 + j] = f2bfh(rv[i] * eg);
          Q3[i * 64 + j] = f2bfh(bhv[i]);
          Q4[i * 64 + j] = f2bfh(khv[i]);
        }
        const float pC = eg;
        GST(float, myslot + 14336 + j * 4, pC);
#pragma unroll
        for (int qq = 0; qq < 4; ++qq) {
          uint4 o;
          o.x = pk2(khv[4 * qq] * pC, khv[4 * qq + 1] * pC);
          o.y = pk2(khv[4 * qq + 2] * pC, khv[4 * qq + 3] * pC);
          o.z = pk2(-bhv[4 * qq] * pC, -bhv[4 * qq + 1] * pC);
          o.w = pk2(-bhv[4 * qq + 2] * pC, -bhv[4 * qq + 3] * pC);
          GST(u32x4, myslot + 4096 + ((q * 64 + qq * 16 + fr) * 16), (u32x4{o.x, o.y, o.z, o.w}));
          uint2 ov;
          ov.x = pk2(vv[4 * qq], vv[4 * qq + 1]);
          ov.y = pk2(vv[4 * qq + 2], vv[4 * qq + 3]);
          GST(u32x2, myslot + 8192 + ((q * 64 + qq * 16 + fr) * 8), (u32x2{ov.x, ov.y}));
        }
        {
          uint4 o0, o1;
          o0.x = pk2(kt[0], kt[1]); o0.y = pk2(kt[2], kt[3]); o0.z = pk2(kt[4], kt[5]); o0.w = pk2(kt[6], kt[7]);
          o1.x = pk2(kt[8], kt[9]); o1.y = pk2(kt[10], kt[11]); o1.z = pk2(kt[12], kt[13]); o1.w = pk2(kt[14], kt[15]);
          *(uint4*)((char*)G + j * 32) = o0;
          *(uint4*)((char*)G + j * 32 + 16) = o1;
          o0.x = pk2(vv[0], vv[1]); o0.y = pk2(vv[2], vv[3]); o0.z = pk2(vv[4], vv[5]); o0.w = pk2(vv[6], vv[7]);
          o1.x = pk2(vv[8], vv[9]); o1.y = pk2(vv[10], vv[11]); o1.z = pk2(vv[12], vv[13]); o1.w = pk2(vv[14], vv[15]);
          *(uint4*)((char*)G + 2048 + j * 32) = o0;
          *(uint4*)((char*)G + 2048 + j * 32 + 16) = o1;
        }
      }
      wave_sync();
      f32x4 aM = {0.f, 0.f, 0.f, 0.f}, aN = aM, aRb = aM, aRk = aM;
#pragma unroll
      for (int s = 0; s < 2; ++s) {
        bf16x8 x1 = *(const bf16x8*)(Q1 + fr * 64 + s * 32 + q * 8);
        bf16x8 x2 = *(const bf16x8*)(Q2 + fr * 64 + s * 32 + q * 8);
        bf16x8 x3 = *(const bf16x8*)(Q3 + fr * 64 + s * 32 + q * 8);
        bf16x8 x4 = *(const bf16x8*)(Q4 + fr * 64 + s * 32 + q * 8);
        aM = MFMA32(x3, x1, aM);
        aN = MFMA32(x4, x1, aN);
        aRb = MFMA32(x3, x2, aRb);
        aRk = MFMA32(x4, x2, aRk);
      }
#pragma unroll
      for (int jj = 0; jj < 4; ++jj) {
        const int ii = 4 * q + jj;
        if (!(ii < fr)) { aM[jj] = 0.f; aN[jj] = 0.f; }
        if (!(ii <= fr)) { aRb[jj] = 0.f; aRk[jj] = 0.f; }
      }
      {
        const int c = lane & 15;
        float tt[16];
#pragma unroll
        for (int t = 0; t < 16; ++t) {
          float acc = (t == c) ? 1.f : 0.f;
#pragma unroll
          for (int i = 0; i < t; ++i) acc -= rlane(aM[i & 3], (i >> 2) * 16 + t) * tt[i];
          tt[t] = acc;
        }
        if (lane < 16) {
#pragma unroll
          for (int t = 0; t < 16; ++t) F[t * 16 + c] = tt[t];
        }
      }
      wave_sync();
      {
        U4 tA, nA, rbA, rkA;
        f32x4 tv = *(const f32x4*)(F + fr * 16 + 4 * q);
        tA.u[0] = pk2(tv[0], tv[1]); tA.u[1] = pk2(tv[2], tv[3]);
        nA.u[0] = pk2(aN[0], aN[1]); nA.u[1] = pk2(aN[2], aN[3]);
        rbA.u[0] = pk2(-aRb[0], -aRb[1]); rbA.u[1] = pk2(-aRb[2], -aRb[3]);
        rkA.u[0] = pk2(aRk[0], aRk[1]); rkA.u[1] = pk2(aRk[2], aRk[3]);
        const f32x4 z4 = {0.f, 0.f, 0.f, 0.f};
#pragma unroll
        for (int nt = 0; nt < 4; ++nt) {
          U4 kB, vB;
          kB.q = *(const uint2*)((const char*)G + (16 * nt + fr) * 32 + 8 * q);
          vB.q = *(const uint2*)((const char*)G + 2048 + (16 * nt + fr) * 32 + 8 * q);
          f32x4 kbar = MFMA16(tA.v, kB.v, z4);
          U4 kbB; kbB.u[0] = pk2(kbar[0], kbar[1]); kbB.u[1] = pk2(kbar[2], kbar[3]);
          f32x4 rtd;
#pragma unroll
          for (int jj = 0; jj < 4; ++jj) rtd[jj] = bf2f(Q2[(4 * q + jj) * 64 + 16 * nt + fr]);
          f32x4 rp = MFMA16(rbA.v, kbB.v, rtd);
          f32x4 nv = MFMA16(nA.v, vB.v, z4);
          U4 nvB; nvB.u[0] = pk2(nv[0], nv[1]); nvB.u[1] = pk2(nv[2], nv[3]);
          f32x4 w2 = MFMA16(tA.v, nvB.v, z4);
          U4 w2B; w2B.u[0] = pk2(w2[0], w2[1]); w2B.u[1] = pk2(w2[2], w2[3]);
          f32x4 yi = MFMA16(rkA.v, vB.v, z4);
          yi = MFMA16(rbA.v, w2B.v, yi);
          const int chan = 16 * nt + fr;
          const int oA = (chan >> 5) * 1024 + ((chan >> 2) & 3) * 256 + ((chan >> 4) & 1) * 8 + (chan & 3) * 2;
#pragma unroll
          for (int jj = 0; jj < 4; ++jj) {
            GST(bf16_t, myslot + oA + (4 * q + jj) * 16, f2bfh(kbar[jj]));
            GST(bf16_t, myslot + 2048 + oA + (4 * q + jj) * 16, f2bfh(rp[jj]));
          }
          GST(u32x2, myslot + 10240 + ((nt * 64 + lane) * 8), (u32x2{w2B.u[0], w2B.u[1]}));
          uint2 yo; yo.x = pk2(yi[0], yi[1]); yo.y = pk2(yi[2], yi[3]);
          GST(u32x2, myslot + 12288 + ((nt * 64 + lane) * 8), (u32x2{yo.x, yo.y}));
        }
      }
    }
    __syncthreads();
    unsigned pfd[2] = {0u, 0u};
    {
      {
        int nr = rnd + 1;
        if (nr < 36) {
          int Ln, basen;
          if (nr < 4) { Ln = CTXL; basen = NLAT + b * CTXL; }
          else { Ln = SEQL; basen = b * SEQL; }
          const int rrn = (nr < 4) ? nr : nr - 4;
          const int sposn = (rrn * 4 + wave) * 16;
          const int t0n = d ? (Ln - 1 - sposn) : sposn;
          const int tlon = d ? (t0n - 15) : t0n;
#pragma unroll
          for (int hlf = 0; hlf < 2; ++hlf) {
            int idx = lane + hlf * 64;
            if (idx < 90) {
              int ga = idx / 18, rr = idx % 18;
              int trow = tlon - 1 + rr;
              int col = (ga == 0) ? (h * 64) : (ga == 1) ? (384 + h * 64) : (ga == 2) ? (768 + h * 64) : (ga == 3) ? (1152 + d * 64) : (1280 + d * 64);
              if (trow >= 0 && trow < Ln) {
                asm volatile("global_load_ubyte %0, %1, off" : "=v"(pfd[hlf]) : "v"(P.p + PT(basen + trow, 256 + col)));
              }
            }
          }
        }
      }
      struct SeqOps { bf16x8 ka0, ka1, ra0, ra1, kb[4]; f32x4 pc[4]; u32x2 vq, w2q, yiq; };
      SeqOps cur, nxt;
#define LOADOPS(O, sc_)                                                          \
  {                                                                               \
    const char* sl = ring + (sc_) * RSLOT;                                        \
    O.ka0 = GLD(bf16x8, sl + lane * 16);                                     \
    O.ka1 = GLD(bf16x8, sl + 1024 + lane * 16);                              \
    O.ra0 = GLD(bf16x8, sl + 2048 + lane * 16);                              \
    O.ra1 = GLD(bf16x8, sl + 3072 + lane * 16);                              \
    _Pragma("unroll") for (int mt = 0; mt < 4; ++mt) {                            \
      O.kb[mt] = GLD(bf16x8, sl + 4096 + (mt * 64 + lane) * 16);             \
      O.pc[mt] = GLD(f32x4, sl + 14336 + (16 * mt + 4 * q) * 4);             \
    }                                                                             \
    O.vq = GLD(u32x2, sl + 8192 + (wave * 64 + lane) * 8);                   \
    O.w2q = GLD(u32x2, sl + 10240 + (wave * 64 + lane) * 8);                 \
    O.yiq = GLD(u32x2, sl + 12288 + (wave * 64 + lane) * 8);                 \
  }
      LOADOPS(cur, 0);
#pragma unroll
      for (int sc = 0; sc < 4; ++sc) {
        if (sc < 3) LOADOPS(nxt, sc + 1);
        bf16x8 B0 = pack8(accS[0], accS[1]);
        bf16x8 B1 = pack8(accS[2], accS[3]);
        f32x4 accU = unpack4(make_uint2(cur.w2q.x, cur.w2q.y));
        accU = MFMA32(cur.ka0, B0, accU);
        accU = MFMA32(cur.ka1, B1, accU);
        f32x4 accY = unpack4(make_uint2(cur.yiq.x, cur.yiq.y));
        accY = MFMA32(cur.ra0, B0, accY);
        accY = MFMA32(cur.ra1, B1, accY);
        U8 z;
        z.u[0] = cur.vq.x; z.u[1] = cur.vq.y;
        z.u[2] = pk2(accU[0], accU[1]); z.u[3] = pk2(accU[2], accU[3]);
#pragma unroll
        for (int mt = 0; mt < 4; ++mt) {
          f32x4 c = accS[mt] * cur.pc[mt];
          accS[mt] = MFMA32(cur.kb[mt], z.v, c);
        }
        const int spos = (rr0 * 4 + sc) * 16;
        if (!(l == 1 && rnd < 4)) {
#pragma unroll
          for (int jj = 0; jj < 4; ++jj) {
            int s = spos + 4 * q + jj;
            int t = d ? (L - 1 - s) : s;
            P.yrec[(size_t)(base + t) * YREC + d * 384 + h * 64 + 16 * wave + fr] = f2bfh(accY[jj]);
          }
        }
        if (sc < 3) cur = nxt;
      }
#undef LOADOPS
    }
    __syncthreads();
    asm volatile("" ::"v"(pfd[0]), "v"(pfd[1]));
  }
}

#define HSLOT 8448
__device__ void hgrn_unit2(const Params& P, int l, int b, int h, int d, char* smem) {
  const int tid = opq(threadIdx.x), lane0 = tid & 63, wave = __builtin_amdgcn_readfirstlane(tid >> 6);
  char* slots = smem;
  char* wsm = smem + 4 * HSLOT + wave * 6144;
  bf16_t* Q1 = (bf16_t*)wsm;
  bf16_t* Q2 = (bf16_t*)(wsm + 2048);
  float* F = (float*)(wsm + 4096);
  char* myslot = slots + wave * HSLOT;
  float lb;
  {
    float x0 = P.hgrn_lb[(d * 2 + 0) * 384 + h * 64 + lane0];
    float x1 = P.hgrn_lb[(d * 2 + 1) * 384 + h * 64 + lane0];
    float mx = fmaxf(x0, x1);
    float e0 = expf(x0 - mx), e1 = expf(x1 - mx);
    float w0 = e0 / (e0 + e1), w1 = e1 / (e0 + e1);
    lb = (l == 0) ? 0.f : fmaxf((w0 + w1) - w0, 0.f);
  }
  f32x4 accS[4];
#pragma unroll
  for (int mt = 0; mt < 4; ++mt) accS[mt] = f32x4{0.f, 0.f, 0.f, 0.f};
  for (int rnd = 0; rnd < 36; ++rnd) {
    int L, base;
    if (rnd < 4) { L = CTXL; base = NLAT + b * CTXL; }
    else { L = SEQL; base = b * SEQL; }
    const int rr0 = (rnd < 4) ? rnd : rnd - 4;
    const int lane = opq(lane0), fr = lane & 15, q = lane >> 4, j = lane;
    const int offA = (j >> 5) * 1024 + ((j >> 2) & 3) * 256 + ((j >> 4) & 1) * 8 + (j & 3) * 2;
    {
      const int spos = (rr0 * 4 + wave) * 16;
      float iv[16], gg[16], kh[16];
      float g = 0.f;
      const int t0 = d ? (L - 1 - spos) : spos;
      const int tlo = d ? (t0 - 15) : t0;
      bf16_t qr[16], ir[16], zr[16];
      {
        __amdgpu_buffer_rsrc_t prs = __builtin_amdgcn_make_buffer_rsrc((void*)P.p, 0, 0x7ffffff0, 0x00020000);
        const int lrow = opq(lane) >> 3, lc8 = lane & 7;
        u32x4 pcs[3][2];
#pragma unroll
        for (int g2 = 0; g2 < 3; ++g2) {
          const int colg = (g2 == 0) ? (1664 + h * 64) : ((g2 == 1) ? (2048 + h * 64) : (2432 + d * 384 + h * 64));
          const int so = __builtin_amdgcn_readfirstlane((PTOFF(colg) + (base + tlo) * 128) * 2);
#pragma unroll
          for (int k = 0; k < 2; ++k) pcs[g2][k] = __builtin_amdgcn_raw_buffer_load_b128(prs, (lrow + 8 * k) * 256 + lc8 * 16, so, 0);
        }
#pragma unroll
        for (int g2 = 0; g2 < 3; ++g2)
#pragma unroll
          for (int k = 0; k < 2; ++k) *(u32x4*)(wsm + (g2 * 16 + lrow + 8 * k) * 128 + lc8 * 16) = pcs[g2][k];
        wave_sync();
#pragma unroll
        for (int i = 0; i < 16; ++i) {
          const int r = d ? (15 - i) : i;
          qr[i] = *(const bf16_t*)(wsm + (0 * 16 + r) * 128 + j * 2);
          ir[i] = *(const bf16_t*)(wsm + (1 * 16 + r) * 128 + j * 2);
          zr[i] = *(const bf16_t*)(wsm + (2 * 16 + r) * 128 + j * 2);
        }
        wave_sync();
      }
#pragma unroll
      for (int i = 0; i < 16; ++i) {
        float qv = bf2f(qr[i]);
        iv[i] = bf2f(ir[i]);
        float z = bf2f(zr[i]);
        float sg = sigmf(z);
        float f = lb + (1.f - lb) * sg;
        float k = (1.f - lb) * (1.f - sg);
        g += __logf(f);
        gg[i] = g;
        kh[i] = k;
        float qt = qv * __expf(g);
        Q1[i * 64 + j] = f2bfh(qt);
        Q2[i * 64 + j] = f2bfh(k * __expf(-g));
        *(bf16_t*)(myslot + offA + i * 16) = f2bfh(qt);
      }
      const float gC = g;
      *(float*)(myslot + 8192 + j * 4) = __expf(gC);
#pragma unroll
      for (int qq = 0; qq < 4; ++qq) {
        uint2 o;
        o.x = pk2(kh[4 * qq] * __expf(gC - gg[4 * qq]), kh[4 * qq + 1] * __expf(gC - gg[4 * qq + 1]));
        o.y = pk2(kh[4 * qq + 2] * __expf(gC - gg[4 * qq + 2]), kh[4 * qq + 3] * __expf(gC - gg[4 * qq + 3]));
        *(uint2*)(myslot + 2048 + ((q * 64 + qq * 16 + fr) * 8)) = o;
        o.x = pk2(iv[4 * qq], iv[4 * qq + 1]);
        o.y = pk2(iv[4 * qq + 2], iv[4 * qq + 3]);
        *(uint2*)(myslot + 4096 + ((q * 64 + qq * 16 + fr) * 8)) = o;
      }
      wave_sync();
      f32x4 aA = {0.f, 0.f, 0.f, 0.f};
#pragma unroll
      for (int s = 0; s < 2; ++s) {
        bf16x8 x1 = *(const bf16x8*)(Q1 + fr * 64 + s * 32 + q * 8);
        bf16x8 x2 = *(const bf16x8*)(Q2 + fr * 64 + s * 32 + q * 8);
        aA = MFMA32(x2, x1, aA);
      }
      wave_sync();
      float oi[16];
#pragma unroll
      for (int t = 0; t < 16; ++t) {
        float o = 0.f;
#pragma unroll
        for (int i = 0; i <= t; ++i) o += rlane(aA[i & 3], (i >> 2) * 16 + t) * iv[i];
        oi[t] = o;
      }
#pragma unroll
      for (int qq = 0; qq < 4; ++qq) {
        uint2 o;
        o.x = pk2(oi[4 * qq], oi[4 * qq + 1]);
        o.y = pk2(oi[4 * qq + 2], oi[4 * qq + 3]);
        *(uint2*)(myslot + 6144 + ((q * 64 + qq * 16 + fr) * 8)) = o;
      }
    }
    __syncthreads();
#pragma unroll 1
    for (int sc = 0; sc < 4; ++sc) {
      const char* sl = slots + sc * HSLOT;
      bf16x8 qa0 = *(const bf16x8*)(sl + lane * 16);
      bf16x8 qa1 = *(const bf16x8*)(sl + 1024 + lane * 16);
      U4 kc[4];
      f32x4 pc[4];
#pragma unroll
      for (int mt = 0; mt < 4; ++mt) {
        kc[mt].q = *(const uint2*)(sl + 2048 + (mt * 64 + lane) * 8);
        pc[mt] = *(const f32x4*)(sl + 8192 + (16 * mt + 4 * q) * 4);
      }
      U4 iq;
      iq.q = *(const uint2*)(sl + 4096 + (wave * 64 + lane) * 8);
      uint2 oiq = *(const uint2*)(sl + 6144 + (wave * 64 + lane) * 8);
      bf16x8 B0 = pack8(accS[0], accS[1]);
      bf16x8 B1 = pack8(accS[2], accS[3]);
      f32x4 accO = unpack4(oiq);
      accO = MFMA32(qa0, B0, accO);
      accO = MFMA32(qa1, B1, accO);
#pragma unroll
      for (int mt = 0; mt < 4; ++mt) {
        f32x4 c = accS[mt] * pc[mt];
        accS[mt] = MFMA16(kc[mt].v, iq.v, c);
      }
      const int spos = (rr0 * 4 + sc) * 16;
      if (!(l == 1 && rnd < 4)) {
#pragma unroll
        for (int jj = 0; jj < 4; ++jj) {
          int s = spos + 4 * q + jj;
          int t = d ? (L - 1 - s) : s;
          P.yrec[(size_t)(base + t) * YREC + 768 + d * 384 + h * 64 + 16 * wave + fr] = f2bfh(accO[jj]);
        }
      }
    }
    __syncthreads();
  }
}

__device__ void mix_tile(const Params& P, int l, int tile, float* sm, int part) {
  const int tid = opq(threadIdx.x), lane = tid & 63, wave = __builtin_amdgcn_readfirstlane(tid >> 6);
  int base, segbase, n, tloc0, L, seq0;
  if (tile < 512) { base = tile * 64; segbase = base; n = 64; tloc0 = 0; L = SEQL; seq0 = (tile >> 5) * SEQL; }
  else {
    int ct = tile - 512;
    int b = ct >> 2;
    tloc0 = (ct & 3) * 64;
    segbase = NLAT + b * CTXL;
    base = segbase + tloc0;
    n = CTXL; L = CTXL; seq0 = segbase;
  }
  float* spv = sm;
  float* spT = sm + 80 * 64;
  float* spw = spT + 64 * 68;
  if (part & 1)
  for (int g = 0; g < 4; ++g) {
    int win = 2 << g, left = win >> 1, right = win - 1 - left;
    {
      float vals[20];
#pragma unroll
      for (int k = 0; k < 20; ++k) {
        int e = tid + k * 256;
        int ii = e >> 6, cch = e & 63;
        int tt = tloc0 - 8 + ii;
        vals[k] = (tt >= 0 && tt < n) ? bf2f(P.p[PT(segbase + tt, g * 64 + cch)]) : 0.f;
      }
      f32x4 wv[4];
#pragma unroll
      for (int k = 0; k < 4; ++k) wv[k] = *(const f32x4*)(P.pool_w + (size_t)(l * 4 + g) * 4096 + (tid + k * 256) * 4);
#pragma unroll
      for (int k = 0; k < 20; ++k) spv[tid + k * 256] = vals[k];
#pragma unroll
      for (int k = 0; k < 4; ++k) *(f32x4*)(spw + (tid + k * 256) * 4) = wv[k];
    }
    __syncthreads();
    for (int e = tid; e < 4096; e += 256) {
      int i = e >> 6, cch = e & 63;
      int t = tloc0 + i;
      int lo = max(t - left, 0), hi = min(t + right, n - 1) + 1;
      float s = 0.f;
      for (int tt = lo; tt < hi; ++tt) s += spv[(tt - tloc0 + 8) * 64 + cch];
      spT[cch * 68 + i] = s * frcp((float)(hi - lo)) - spv[(i + 8) * 64 + cch];
    }
    __syncthreads();
    const int col = g * 64 + lane;
    float gatev[16];
#pragma unroll
    for (int r = 0; r < 16; ++r) gatev[r] = bf2f(P.p[PT(base + wave * 16 + r, 3200 + col)]);
    float acc[16];
#pragma unroll
    for (int r = 0; r < 16; ++r) acc[r] = 0.f;
#pragma unroll 4
    for (int cch = 0; cch < 64; ++cch) {
      float w = spw[cch * 64 + lane];
      const f32x4* tp = (const f32x4*)(spT + cch * 68 + wave * 16);
      f32x4 t0 = tp[0], t1 = tp[1], t2 = tp[2], t3 = tp[3];
#pragma unroll
      for (int e = 0; e < 4; ++e) {
        acc[e] += t0[e] * w; acc[4 + e] += t1[e] * w; acc[8 + e] += t2[e] * w; acc[12 + e] += t3[e] * w;
      }
    }
    float psc = P.pool_scale[l * 256 + col];
#pragma unroll
    for (int r = 0; r < 16; ++r) {
      int token = base + wave * 16 + r;
      P.xn[XT(token, col)] = f2bf(acc[r] * psc * siluf(gatev[r]));
    }
    __syncthreads();
  }
  if (part & 2) {
    const int grp = lane >> 4, c4 = (lane & 15) * 4;
#pragma unroll 1
    for (int pass = 0; pass < 3; ++pass) {
      const int hh = pass * 4 + grp;
      const bool isr = hh < 6;
      const int ch = (isr ? hh : hh - 6) * 64 + c4;
      const int uc = 768 + ch;
      const int oya = isr ? ch : 768 + ch, oyb = isr ? 384 + ch : 1152 + ch;
      const int ogate = 3200 + (isr ? 256 : 640) + ch, omix = (isr ? 256 : 640) + ch;
      f32x4 s0 = {0.f, 0.f, 0.f, 0.f}, s1 = s0, s2 = s0, gg = s0, gb = s0;
      if (isr) {
        s0 = *(const f32x4*)(P.rwkv_shift + (l * 3 + 0) * 1408 + uc);
        s1 = *(const f32x4*)(P.rwkv_shift + (l * 3 + 1) * 1408 + uc);
        s2 = *(const f32x4*)(P.rwkv_shift + (l * 3 + 2) * 1408 + uc);
        gg = *(const f32x4*)(P.rwkv_gn_g + l * 384 + ch);
        gb = *(const f32x4*)(P.rwkv_gn_b + l * 384 + ch);
      } else {
        gg = *(const f32x4*)(P.hgrn_norm_g + l * 384 + ch);
      }
#pragma unroll 1
      for (int r0 = 0; r0 < 16; r0 += 4) {
        uint2 ya[4], yb[4], vm[4], vl[4], vh[4], gt[4];
        float bon[4];
#pragma unroll
        for (int u = 0; u < 4; ++u) {
          const int token = base + wave * 16 + r0 + u;
          const int t = token - seq0;
          const bf16_t* yr = P.yrec + (size_t)token * YREC;
          ya[u] = *(const uint2*)(yr + oya);
          yb[u] = *(const uint2*)(yr + oyb);
          gt[u] = *(const uint2*)(P.p + PT(token, ogate));
          vm[u] = make_uint2(0u, 0u); vl[u] = vm[u]; vh[u] = vm[u]; bon[u] = 0.f;
          if (isr) {
            bon[u] = P.bonus[(size_t)token * 12 + hh] + P.bonus[(size_t)token * 12 + 6 + hh];
            const bf16_t* pv = P.p + PT(token, 256 + uc);
            vm[u] = *(const uint2*)pv;
            if (t > 0) vl[u] = *(const uint2*)(pv - 128);
            if (t < L - 1) vh[u] = *(const uint2*)(pv + 128);
          }
        }
#pragma unroll
        for (int u = 0; u < 4; ++u) {
          const int token = base + wave * 16 + r0 + u;
          f32x4 y = unpack4(ya[u]) + unpack4(yb[u]);
          f32x4 gate = unpack4(gt[u]);
          f32x4 o;
          if (isr) {
            float mu = rsum16(y[0] + y[1] + y[2] + y[3]) * (1.f / 64.f);
            f32x4 dl = y - mu;
            float var = rsum16(dl[0] * dl[0] + dl[1] * dl[1] + dl[2] * dl[2] + dl[3] * dl[3]) * (1.f / 64.f);
            float rs = __builtin_amdgcn_rsqf(var + GN_EPS_F);
            f32x4 v = s1 * unpack4(vm[u]) + s0 * unpack4(vl[u]) + s2 * unpack4(vh[u]);
#pragma unroll
            for (int e = 0; e < 4; ++e) o[e] = (dl[e] * rs * gg[e] + gb[e] + bon[u] * v[e]) * siluf(gate[e]);
          } else {
            float ms = rsum16(y[0] * y[0] + y[1] * y[1] + y[2] * y[2] + y[3] * y[3]) * (1.f / 64.f);
            float rs = __builtin_amdgcn_rsqf(ms + RMS_EPS_F);
#pragma unroll
            for (int e = 0; e < 4; ++e) o[e] = y[e] * rs * gg[e] * siluf(gate[e]);
          }
          uint2 ov;
          ov.x = pk2(o[0], o[1]); ov.y = pk2(o[2], o[3]);
          *(uint2*)(P.xn + XT(token, omix)) = ov;
        }
      }
    }
  }
}

#define XB_TMO      128
#define XB_XCNT(j)  (256  + 64 * (j))
#define XB_XSUB(j)  (1280 + 64 * (j))
#define XB_XGEN(j)  (2304 + 64 * (j))
#define XB_TOP      3328
#define XB_TOPGEN   3392
#define XCD_BAR_WORDS 3456
#define XB_SPIN_CAP (1u << 18)
__device__ __forceinline__ unsigned xb_ld(unsigned* p) { return __hip_atomic_load(p, __ATOMIC_RELAXED, __HIP_MEMORY_SCOPE_AGENT); }
__device__ __forceinline__ unsigned xb_add(unsigned* p, unsigned v) { return __hip_atomic_fetch_add(p, v, __ATOMIC_RELAXED, __HIP_MEMORY_SCOPE_AGENT); }
__device__ __forceinline__ unsigned xb_xcc_id() { return (unsigned)__builtin_amdgcn_s_getreg((3 << 11) | 20) & 0xFu; }
#define XB_SPIN(cond, bar) do { unsigned _sp = 0; while (cond) { __builtin_amdgcn_s_sleep(1); \
    if ((++_sp & 255u) == 0u) { if (xb_ld(&(bar)[XB_TMO])) break; if (_sp > XB_SPIN_CAP) { atomicAdd(&(bar)[XB_TMO], 1u); break; } } } } while (0)
__device__ __forceinline__ void xcd_barrier(unsigned* bar, unsigned x, unsigned nloc, unsigned nx) {
  asm volatile("s_waitcnt vmcnt(0)" ::: "memory");
  __syncthreads();
  if (threadIdx.x == 0) {
    __builtin_amdgcn_s_waitcnt(0);
    const unsigned old = xb_add(&bar[XB_XSUB(x)], 1u);
    const unsigned gen = old / nloc;
    if (old + 1u == (gen + 1u) * nloc) {
      __builtin_amdgcn_fence(__ATOMIC_RELEASE, "agent");
      asm volatile("s_waitcnt vmcnt(0)" ::: "memory");
      const unsigned og = xb_add(&bar[XB_TOP], 1u);
      const unsigned tg = og / nx;
      if (og + 1u == (tg + 1u) * nx) xb_add(&bar[XB_TOPGEN], 1u);
      else XB_SPIN(xb_ld(&bar[XB_TOPGEN]) == tg, bar);
      __builtin_amdgcn_fence(__ATOMIC_ACQUIRE, "agent");
      xb_add(&bar[XB_XGEN(x)], 1u);
      asm volatile("s_waitcnt vmcnt(0)" ::: "memory");
    } else {
      XB_SPIN(xb_ld(&bar[XB_XGEN(x)]) == gen, bar);
      __builtin_amdgcn_fence(__ATOMIC_ACQUIRE, "agent");
      asm volatile("s_waitcnt vmcnt(0)" ::: "memory");
    }
  }
  __syncthreads();
}

__device__ void p0_unit(const Params& P, int u, float* smf) {
  if (u < 2 * 1056) {
    int l = u / 1056, r = u % 1056;
    transpose_tile(P.w_in + (size_t)l * 1024 * DIN, DIN, P.WtIn + (size_t)l * DIN * 1024, r / 66, r % 66, smf);
  } else if (u < 2 * 1056 + 2 * 256) {
    int v = u - 2 * 1056;
    int l = v / 256, r = v % 256;
    transpose_tile(P.w_out + (size_t)l * 1024 * 1024, 1024, P.WtOut + (size_t)l * 1024 * 1024, r / 16, r % 16, smf);
  } else if (u < 2 * 1056 + 512 + 384) {
    int v = u - 2 * 1056 - 512;
    mod_unit(P, v / 192, v % 192, smf);
  } else {
    int v = u - 2 * 1056 - 512 - 384;
    int which = v / 24, r = v % 24;
    const float* src = (which ? P.rwkv_a_up : P.rwkv_w_up) + (size_t)(r / 6) * 64 * 384 + (r % 6) * 64;
    bf16_t* dst = P.loraT + (size_t)v * 4096;
    for (int e = opq(threadIdx.x); e < 4096; e += 256) {
      int jj = e >> 6, m = e & 63;
      dst[e] = f2bf(src[m * 384 + jj]);
    }
    __syncthreads();
  }
}

__global__ void __launch_bounds__(256, 2) fwd_megakernel(Params P) {
  cg::grid_group grid = cg::this_grid();
  __shared__ __attribute__((aligned(16))) char smem[SMEM_BYTES];
  float* smf = (float*)smem;
  const int bid = blockIdx.x, nblk = gridDim.x;
  const unsigned xcc = xb_xcc_id();
  if (threadIdx.x == 0) *(unsigned*)smem = xb_add(&P.bar[XB_XCNT(xcc)], 1u);
  __syncthreads();
  const int xslot = __builtin_amdgcn_readfirstlane(*(const unsigned*)smem);
  __syncthreads();

  const bool defer_p0 = nblk > 384;
  for (int rep = 0; rep < REP_P0; ++rep) {
    if (defer_p0) {
      for (int e = bid; e < 1272; e += nblk) {
        int u;
        if (e < 192) u = 2624 + e;
        else if (e < 216) { int le = e - 192; u = 3008 + (le / 12) * 24 + (le % 12); }
        else u = e - 216;
        p0_unit(P, u, smf);
      }
    } else {
      for (int u = bid; u < 3056; u += nblk) p0_unit(P, u, smf);
    }
  }
  if (gridDim.x == 0x7fffffffu) grid.sync();
  unsigned nloc = 0u, nxc = 0u, nlow = 0u;
  {
    __syncthreads();
    if (threadIdx.x == 0) {
      unsigned sp = 0u, a = 0u, bq = 0u, cq = 0u;
      for (;;) {
        unsigned sum = 0u;
        a = 0u; bq = 0u; cq = 0u;
#pragma unroll
        for (unsigned jx = 0; jx < 16; ++jx) {
          const unsigned c = xb_ld(&P.bar[XB_XCNT(jx)]);
          sum += c;
          bq += (c > 0u) ? 1u : 0u;
          cq += (jx < 8u && c > 0u) ? 1u : 0u;
          a = (jx == xcc) ? c : a;
        }
        if (sum == gridDim.x) break;
        __builtin_amdgcn_s_sleep(1);
        if ((++sp & 255u) == 0u) { if (xb_ld(&P.bar[XB_TMO])) break; if (sp > XB_SPIN_CAP) { atomicAdd(&P.bar[XB_TMO], 1u); break; } }
      }
      ((unsigned*)smem)[0] = a; ((unsigned*)smem)[1] = bq; ((unsigned*)smem)[2] = cq;
    }
    __syncthreads();
    nloc = ((const unsigned*)smem)[0]; nxc = ((const unsigned*)smem)[1]; nlow = ((const unsigned*)smem)[2];
    __syncthreads();
    nlow = __builtin_amdgcn_readfirstlane(nlow);
    nloc = __builtin_amdgcn_readfirstlane(nloc > 0u ? nloc : 1u);
    nxc = __builtin_amdgcn_readfirstlane(nxc > 0u ? nxc : 1u);
  }
  xcd_barrier(P.bar, xcc, nloc, nxc);

  for (int l = 0; l < 2; ++l) {
    ln_phase(P, l);
    xcd_barrier(P.bar, xcc, nloc, nxc);
    for (int rep = 0; rep < REP_G1; ++rep) {
      if (nxc == 8u && nlow == 8u) {
        const int xcd = (int)xcc, slot = xslot, nslot = (int)nloc;
        for (int i = slot; i < 36 * 33; i += nslot) {
          int mg = i / 132, r = i % 132;
          int nt = r >> 2, mt = xcd * 36 + mg * 4 + (r & 3);
          gemm_tile<0>(P, l, P.xn, P.WtIn + (size_t)l * DIN * 1024, mt * 128, nt * 128, smem);
        }
      } else {
        for (int t = bid; t < 288 * 33; t += nblk) {
          int mt = t / 33, nt = t % 33;
          gemm_tile<0>(P, l, P.xn, P.WtIn + (size_t)l * DIN * 1024, mt * 128, nt * 128, smem);
        }
      }
    }
    xcd_barrier(P.bar, xcc, nloc, nxc);
    const bool grid512 = (nblk == 512);
    int sidx = -1, nside = 0;
    if (grid512) { nside = 128; sidx = (bid >= 192 && bid < 256) ? (bid - 192) : ((bid >= 448) ? (64 + bid - 448) : -1); }
    else if (nblk > 384) { nside = nblk - 384; sidx = (bid >= 384) ? (bid - 384) : -1; }
    for (int rep = 0; rep < REP_SCAN; ++rep)
    for (int u0 = bid; u0 < (grid512 ? 512 : 384); u0 += nblk) {
      int u = u0;
      if (grid512) {
        if (u0 < 192) u = u0;
        else if (u0 >= 256 && u0 < 448) u = 192 + (u0 - 256);
        else continue;
      }
      int type = u / 192, rem = u % 192;
      int d = rem / 96, b = (rem % 96) / 6, h = rem % 6;
      if (type == 0) rwkv_unit2(P, l, b, h, d, smem, rem);
      else hgrn_unit2(P, l, b, h, d, smem);
    }
    const bool pool_in_scan = nblk > 384;
    if (pool_in_scan && sidx >= 0) {
      const int ntile_p = (l == 0) ? 576 : 512;
      for (int t = sidx; t < ntile_p; t += nside) mix_tile(P, l, t, smf, 1);
      if (l == 0) {
        for (int f = sidx; f < 1784; f += nside) {
          int u;
          if (f < 1056) u = 1056 + f;
          else if (f < 1568) u = 2112 + (f - 1056);
          else if (f < 1760) u = 2624 + 192 + (f - 1568);
          else { int lf = f - 1760; u = 3008 + (lf / 12) * 24 + 12 + (lf % 12); }
          p0_unit(P, u, smf);
        }
      }
    }
    xcd_barrier(P.bar, xcc, nloc, nxc);
    {
      int ntile = (l == 0) ? 576 : 512;
      for (int rep = 0; rep < REP_MIX; ++rep)
      for (int t = bid; t < ntile; t += nblk) mix_tile(P, l, t, smf, (nblk > 384) ? 2 : 3);
    }
    xcd_barrier(P.bar, xcc, nloc, nxc);
    {
      int nmt = (l == 0) ? 288 : 256;
      for (int rep = 0; rep < ((l == 0) ? REP_G2 : 1); ++rep) {
        if (nxc == 8u && nlow == 8u) {
          const int xcd = (int)xcc, slot = xslot, nslot = (int)nloc, mpx = nmt >> 3;
          for (int i = slot; i < mpx * 8; i += nslot) {
            int mt = xcd * mpx + (i >> 3), nt = i & 7;
            gemm_tile<1>(P, l, P.xn, P.WtOut + (size_t)l * 1024 * 1024, mt * 128, nt * 128, smem);
          }
        } else {
          for (int t = bid; t < nmt * 8; t += nblk) {
            int mt = t / 8, nt = t % 8;
            gemm_tile<1>(P, l, P.xn, P.WtOut + (size_t)l * 1024 * 1024, mt * 128, nt * 128, smem);
          }
        }
      }
    }
    xcd_barrier(P.bar, xcc, nloc, nxc);
  }
  final_ln_phase(P);
}

extern "C" void kernel_launch(void* const* d_in, const int* in_sizes, int n_in, void* d_out, int out_size, void* d_ws,
                              size_t ws_size, hipStream_t stream) {
  static int grid_blocks = 0;
  if (!grid_blocks) {
    int dev = 0, cus = 0, per_cu = 0;
    hipGetDevice(&dev);
    hipDeviceGetAttribute(&cus, hipDeviceAttributeMultiprocessorCount, dev);
    hipOccupancyMaxActiveBlocksPerMultiprocessor(&per_cu, fwd_megakernel, 256, 0);
    if (per_cu > 2) per_cu = 2;
    grid_blocks = cus * per_cu;
  }
  Params p{};
  const float* const* in = (const float* const*)d_in;
  p.x = in[0]; p.c = in[1]; p.ctx = in[2]; p.c_ctx = in[3]; p.mod_w = in[4]; p.mod_b = in[5]; p.w_in = in[6];
  p.rwkv_shift = in[7]; p.pool_w = in[8]; p.pool_scale = in[9]; p.rwkv_w0 = in[10]; p.rwkv_w_up = in[11];
  p.rwkv_a0 = in[12]; p.rwkv_a_up = in[13]; p.rwkv_k_k = in[14]; p.rwkv_k_a = in[15]; p.rwkv_r_k = in[16];
  p.rwkv_gn_g = in[17]; p.rwkv_gn_b = in[18]; p.hgrn_lb = in[19]; p.hgrn_norm_g = in[20]; p.w_out = in[21];
  p.ln_g = in[22]; p.ln_b = in[23];
  p.out = (float*)d_out;
  char* ws = (char*)d_ws;
  size_t off = 0;
  auto take = [&](size_t bytes) { char* r = ws + off; off += (bytes + 255) & ~(size_t)255; return r; };
  p.WtIn = (bf16_t*)take((size_t)2 * DIN * 1024 * 2);
  p.WtOut = (bf16_t*)take((size_t)2 * 1024 * 1024 * 2);
  p.mod = (float*)take((size_t)2 * 17 * 3072 * 4);
  p.xn = (bf16_t*)take((size_t)NTOK * 1024 * 2);
  p.p = (bf16_t*)take((size_t)NTOK * DIN * 2);
  p.yrec = (bf16_t*)take((size_t)NTOK * YREC * 2);
  p.bonus = (float*)take((size_t)NTOK * 12 * 4);
  p.loraT = (bf16_t*)take((size_t)48 * 4096 * 2);
  p.ring = take((size_t)192 * 4 * RSLOT);
  p.bar = (unsigned*)take((size_t)XCD_BAR_WORDS * 4);
  p.hprectx = (float*)p.p;
  if (off > ws_size) { fprintf(stderr, "workspace too small: need %zu have %zu\n", off, ws_size); return; }
  hipMemsetAsync(p.bar, 0, (size_t)XCD_BAR_WORDS * 4, stream);
  void* args[] = {&p};
  hipError_t e = hipLaunchCooperativeKernel((void*)fwd_megakernel, dim3(grid_blocks), dim3(256), args, 0, stream);
  if (e != hipSuccess) fprintf(stderr, "cooperative launch failed: %s (grid %d)\n", hipGetErrorString(e), grid_blocks);
}
```
